# Optimizing an MI355X kernel written in HIP

```python
import math
import jax, jax.numpy as jnp
from jax import lax
import numpy as np

D_MODEL = 2048
BATCH = 4
SEQ = 4096
DEPTH = 1

CHUNK = 64
Q_BLOCK = 128
RMS_EPS = 1e-6

A_HEADS = 8
A_QK_DIM = 64
A_V_DIM = 2 * A_QK_DIM
A_WIDTH = A_HEADS * A_V_DIM
Q_COLS = A_HEADS * 2 * A_QK_DIM
K_COLS = Q_COLS
V_COLS = A_WIDTH

LRU_WIDTH = D_MODEL // 2
LRU_BLOCKS = 8
LRU_BLOCK_DIM = LRU_WIDTH // LRU_BLOCKS
CONV_WIDTH = 4
LRU_C = 8.0

REL_BUCKETS = 32
REL_MAX_DIST = 128

N_BRANCH = 2
IN_COLS = Q_COLS + K_COLS + V_COLS + 2 * LRU_WIDTH + N_BRANCH * D_MODEL

N_EXPERTS = 32
TOP_K = 4
D_EXPERT = D_MODEL
SWIGLU_LIMIT = 7.0
SWIGLU_ALPHA = 1.702
MOE_BLOCK = 128

kernel_name = 'hybrid_diffattn_rglru_moe_block'


def rmsnorm(x, g):
    xf = x.astype(jnp.float32)
    y = xf * lax.rsqrt(jnp.mean(xf * xf, axis=-1, keepdims=True) + RMS_EPS)
    return (y * g.astype(jnp.float32)).astype(x.dtype)


def t5_bucket(rel):
    nb = REL_BUCKETS // 2
    max_exact = nb // 2
    ret = jnp.where(rel > 0, nb, 0)
    n = jnp.abs(rel)
    nf = jnp.maximum(n, 1).astype(jnp.float32)
    large = max_exact + (jnp.log(nf / max_exact) / math.log(REL_MAX_DIST / max_exact)
                         * (nb - max_exact)).astype(jnp.int32)
    large = jnp.minimum(large, nb - 1)
    return ret + jnp.where(n < max_exact, n, large)


def diff_attention(q, k, v, rel_table, lam, q_gain, k_gain, sub_gain, lam_init):
    B, S = q.shape[0], q.shape[1]
    n_qb = S // Q_BLOCK
    q = rmsnorm(q, q_gain) * (A_QK_DIM ** -0.5)
    k = rmsnorm(k, k_gain)
    kpos = jnp.arange(S, dtype=jnp.int32)
    q_blocks = jnp.moveaxis(q.reshape(B, n_qb, Q_BLOCK, A_HEADS, 2, A_QK_DIM), 1, 0)
    table = rel_table.astype(jnp.float32)

    def block(args):
        qi, i = args
        qpos = i * Q_BLOCK + jnp.arange(Q_BLOCK, dtype=jnp.int32)
        bias = table[t5_bucket(kpos[None, :] - qpos[:, None])]
        allowed = (kpos[None, :] // CHUNK) <= (qpos[:, None] // CHUNK)
        logits = jnp.einsum('bqhmd,bkhmd->bhmqk', qi, k, preferred_element_type=jnp.float32)
        logits = logits + jnp.transpose(bias, (2, 0, 1))[None, :, None]
        logits = jnp.where(allowed, logits, jnp.finfo(jnp.float32).min)
        p = jax.nn.softmax(logits, axis=-1)
        diff = p[:, :, 0] - lam * p[:, :, 1]
        return jnp.einsum('bhqk,bkhd->bqhd', diff, v.astype(jnp.float32))

    o = lax.map(block, (q_blocks, jnp.arange(n_qb, dtype=jnp.int32)))
    o = jnp.moveaxis(o, 0, 1).reshape(B, S, A_HEADS, A_V_DIM)
    o = rmsnorm(o, sub_gain) * (1.0 - lam_init)
    return o.reshape(B, S, A_WIDTH).astype(v.dtype)


def causal_conv(x, w, b):
    C = x.shape[-1]
    y = lax.conv_general_dilated(x, w[:, None, :].astype(x.dtype), window_strides=(1,),
                                 padding=[(CONV_WIDTH - 1, 0)],
                                 dimension_numbers=('NWC', 'WIO', 'NWC'),
                                 feature_group_count=C)
    return y + b.astype(x.dtype)


def rg_lru(x, w_a, b_a, w_x, b_x, lam_param):
    B, S, C = x.shape
    xf = x.astype(jnp.float32)
    xb = xf.reshape(B, S, LRU_BLOCKS, LRU_BLOCK_DIM)
    r = jax.nn.sigmoid(jnp.einsum('bsgi,gij->bsgj', xb, w_a.astype(jnp.float32)).reshape(B, S, C)
                       + b_a.astype(jnp.float32))
    i = jax.nn.sigmoid(jnp.einsum('bsgi,gij->bsgj', xb, w_x.astype(jnp.float32)).reshape(B, S, C)
                       + b_x.astype(jnp.float32))
    log_a = -LRU_C * r * jax.nn.softplus(-lam_param.astype(jnp.float32))
    a = jnp.exp(log_a)
    mult = jnp.sqrt(-jnp.expm1(2.0 * log_a))
    u = mult * (i * xf)

    def combine(c1, c2):
        a1, b1 = c1
        a2, b2 = c2
        return a1 * a2, a2 * b1 + b2

    _, h = lax.associative_scan(combine, (a, u), axis=1)
    return h.astype(x.dtype)


def moe(h, w_router, b_router, w1, b1, w2, b2):
    B, S, D = h.shape
    T = B * S
    xt = h.reshape(T, D)
    logits = (xt @ w_router + b_router).astype(jnp.float32)
    top_val, top_idx = lax.top_k(logits, TOP_K)
    gate = jax.nn.softmax(top_val, axis=-1)
    A = T * TOP_K
    e_flat = top_idx.reshape(A).astype(jnp.int32)
    tok_flat = jnp.arange(A, dtype=jnp.int32) // TOP_K
    g_flat = gate.reshape(A)
    order = jnp.argsort(e_flat, stable=True)
    e_sorted = e_flat[order]
    counts = jnp.bincount(e_flat, length=N_EXPERTS)
    starts = jnp.cumsum(counts) - counts
    padded = (counts + MOE_BLOCK - 1) // MOE_BLOCK * MOE_BLOCK
    pad_ends = jnp.cumsum(padded)
    pad_starts = pad_ends - padded
    dest = pad_starts[e_sorted] + (jnp.arange(A, dtype=jnp.int32) - starts[e_sorted])
    n_blocks = A // MOE_BLOCK + N_EXPERTS
    P = n_blocks * MOE_BLOCK
    buf_tok = jnp.zeros((P,), jnp.int32).at[dest].set(tok_flat[order])
    buf_gate = jnp.zeros((P,), jnp.float32).at[dest].set(g_flat[order])
    block_start = jnp.arange(n_blocks, dtype=jnp.int32) * MOE_BLOCK
    block_expert = jnp.minimum(jnp.searchsorted(pad_ends, block_start, side='right'),
                               N_EXPERTS - 1).astype(jnp.int32)

    def expert_block(args):
        tok, e = args
        hid = xt[tok] @ w1[e] + b1[e]
        x_glu = jnp.minimum(hid[:, ::2], SWIGLU_LIMIT)
        x_lin = jnp.clip(hid[:, 1::2], -SWIGLU_LIMIT, SWIGLU_LIMIT)
        act = x_glu * jax.nn.sigmoid(SWIGLU_ALPHA * x_glu) * (x_lin + 1.0)
        return act @ w2[e] + b2[e]

    out = lax.map(expert_block, (buf_tok.reshape(n_blocks, MOE_BLOCK), block_expert))
    out = out.reshape(P, D).astype(jnp.float32) * buf_gate[:, None]
    y = jnp.zeros((T, D), jnp.float32).at[buf_tok].add(out)
    return y.reshape(B, S, D).astype(h.dtype)


def setup_inputs(seed: int = 0) -> dict:
    key = jax.random.key(seed)
    ks = jax.random.split(key, 32)
    L, D = DEPTH, D_MODEL
    f32 = jnp.float32

    def nrm(k, shape, scale):
        return jax.random.normal(k, shape, f32) * scale

    def gain(k, shape):
        return 1.0 + 0.01 * jax.random.normal(k, shape, f32)

    a0 = jax.random.uniform(ks[17], (L, LRU_WIDTH), f32, 0.9, 0.999)
    s0 = a0 ** (1.0 / LRU_C)
    lru_lambda = jnp.log(s0) - jnp.log1p(-s0)
    return {
        'x': jax.random.normal(ks[0], (BATCH, SEQ, D), f32),
        'ln_mix': gain(ks[1], (L, D)),
        'w_in': nrm(ks[2], (L, D, IN_COLS), D ** -0.5),
        'b_gate': nrm(ks[3], (L, N_BRANCH * D), 0.01),
        'q_gain': gain(ks[4], (L, A_QK_DIM)),
        'k_gain': gain(ks[5], (L, A_QK_DIM)),
        'lambda_q1': nrm(ks[6], (L, A_QK_DIM), 0.1),
        'lambda_k1': nrm(ks[7], (L, A_QK_DIM), 0.1),
        'lambda_q2': nrm(ks[8], (L, A_QK_DIM), 0.1),
        'lambda_k2': nrm(ks[9], (L, A_QK_DIM), 0.1),
        'sub_gain': gain(ks[10], (L, A_V_DIM)),
        'rel_table': nrm(ks[11], (REL_BUCKETS, A_HEADS), 0.5),
        'conv_w': nrm(ks[12], (L, CONV_WIDTH, LRU_WIDTH), CONV_WIDTH ** -0.5),
        'conv_b': nrm(ks[13], (L, LRU_WIDTH), 0.01),
        'lru_wa': nrm(ks[14], (L, LRU_BLOCKS, LRU_BLOCK_DIM, LRU_BLOCK_DIM), LRU_BLOCK_DIM ** -0.5),
        'lru_ba': nrm(ks[15], (L, LRU_WIDTH), 0.01),
        'lru_wx': nrm(ks[16], (L, LRU_BLOCKS, LRU_BLOCK_DIM, LRU_BLOCK_DIM), LRU_BLOCK_DIM ** -0.5),
        'lru_bx': nrm(ks[18], (L, LRU_WIDTH), 0.01),
        'lru_lambda': lru_lambda,
        'w_branch_a': nrm(ks[19], (L, A_WIDTH, D), A_WIDTH ** -0.5),
        'w_branch_b': nrm(ks[20], (L, LRU_WIDTH, D), LRU_WIDTH ** -0.5),
        'w_out': nrm(ks[21], (L, D, D), D ** -0.5),
        'ln_ffn': gain(ks[22], (L, D)),
        'w_router': nrm(ks[23], (L, D, N_EXPERTS), D ** -0.5),
        'b_router': nrm(ks[24], (L, N_EXPERTS), 0.01),
        'w1': nrm(ks[25], (L, N_EXPERTS, D, 2 * D_EXPERT), D ** -0.5),
        'b1': nrm(ks[26], (L, N_EXPERTS, 2 * D_EXPERT), 0.01),
        'w2': nrm(ks[27], (L, N_EXPERTS, D_EXPERT, D), D_EXPERT ** -0.5),
        'b2': nrm(ks[28], (L, N_EXPERTS, D), 0.01),
    }


def reference(x, ln_mix, w_in, b_gate, q_gain, k_gain, lambda_q1, lambda_k1, lambda_q2, lambda_k2,
              sub_gain, rel_table, conv_w, conv_b, lru_wa, lru_ba, lru_wx, lru_bx, lru_lambda,
              w_branch_a, w_branch_b, w_out, ln_ffn, w_router, b_router, w1, b1, w2, b2):
    B, S, D = x.shape
    cuts = [Q_COLS, Q_COLS + K_COLS, Q_COLS + K_COLS + V_COLS,
            Q_COLS + K_COLS + V_COLS + LRU_WIDTH, Q_COLS + K_COLS + V_COLS + 2 * LRU_WIDTH]
    for l in range(DEPTH):
        h = rmsnorm(x, ln_mix[l])
        proj = jnp.einsum('bsd,dc->bsc', h, w_in[l])
        q, k, v, x_lru, g_lru, gate_logits = jnp.split(proj, cuts, axis=-1)
        q = q.reshape(B, S, A_HEADS, 2, A_QK_DIM)
        k = k.reshape(B, S, A_HEADS, 2, A_QK_DIM)
        v = v.reshape(B, S, A_HEADS, A_V_DIM)

        lam_init = 0.8 - 0.6 * math.exp(-0.3 * l)
        lam = (jnp.exp(jnp.sum(lambda_q1[l].astype(jnp.float32) * lambda_k1[l].astype(jnp.float32)))
               - jnp.exp(jnp.sum(lambda_q2[l].astype(jnp.float32) * lambda_k2[l].astype(jnp.float32)))
               + lam_init)
        o_a = diff_attention(q, k, v, rel_table, lam, q_gain[l], k_gain[l], sub_gain[l], lam_init)

        xr = causal_conv(x_lru, conv_w[l], conv_b[l])
        hr = rg_lru(xr, lru_wa[l], lru_ba[l], lru_wx[l], lru_bx[l], lru_lambda[l])
        o_b = hr * jax.nn.gelu(g_lru)

        y_a = jnp.einsum('bsc,cd->bsd', o_a, w_branch_a[l])
        y_b = jnp.einsum('bsc,cd->bsd', o_b, w_branch_b[l])
        g = jax.nn.sigmoid(gate_logits + b_gate[l]).reshape(B, S, N_BRANCH, D)
        mixed = g[:, :, 0] * y_a + g[:, :, 1] * y_b
        x = x + jnp.einsum('bsd,de->bse', mixed, w_out[l])

        x = x + moe(rmsnorm(x, ln_ffn[l]), w_router[l], b_router[l], w1[l], b1[l], w2[l], b2[l])
    return x
```

```cpp
#include <hip/hip_runtime.h>
#include <cstdio>
#include <cstdint>
namespace pg8 {
#define PG8_LAS __attribute__((address_space(3)))
typedef unsigned short bf16_t;
typedef short bf16x8 __attribute__((ext_vector_type(8)));
typedef float f32x4 __attribute__((ext_vector_type(4)));
typedef unsigned u32x4 __attribute__((ext_vector_type(4)));
constexpr int BM = 256, BK = 64, HALF = 128, HTB = HALF * BK * 2  , STAGE_BYTES = 8 * HTB, NXCD = 8, WGM = 8;

__host__ __device__ __forceinline__ int lds_byte(int r, int c) { const int st = (r >> 4) * 2 + (c >> 5), rr = r & 15, cc = c & 31, ob = rr * 64 + cc * 2; return st * 1024 + (ob ^ (((ob >> 9) & 1) << 5)); }
__host__ __device__ __forceinline__ void stage_rc(int b, int& R, int& C) { const int st = b / 1024, sb = b % 1024, swz = sb ^ (((sb >> 9) & 1) << 5); R = (st >> 1) * 16 + swz / 64; C = (st & 1) * 32 + (swz % 64) / 2; }
__host__ __device__ __forceinline__ int perm32(int rho) { const int n = rho >> 4, i = rho & 15; return 8 * (i >> 2) + 4 * n + (i & 3); }

struct Unit { int pm, pn; };
struct Gemm { const bf16_t* A; const bf16_t* Bt; int M, N, K, lda, ldb; };

struct StaticOrder {
    int nM, nN, nwg, G, c; const PG8_LAS int* texp; size_t estride;
    __host__ __device__ void init(int M, int N, int G_, int c_) { nM = M / BM; nN = N / BM; nwg = nM * nN; G = G_; c = c_; texp = nullptr; estride = 0; }
    __device__ __forceinline__ size_t boff(const Unit& u) const { return texp ? (size_t)texp[u.pm] * estride : (size_t)0; }
    __host__ __device__ bool next(int i, Unit& u) const {
        const long L = (long)i * G + c; if (L >= nwg) return false;
        int wgid = (int)L; { const int q = nwg / NXCD, r = nwg % NXCD, xcd = wgid % NXCD, off = wgid / NXCD; wgid = (xcd < r ? xcd * (q + 1) : r * (q + 1) + (xcd - r) * q) + off; }
        const int nig = WGM * nN, gid = wgid / nig, fm = gid * WGM, gsz = (nM - fm) < WGM ? (nM - fm) : WGM;
        u.pm = fm + ((wgid % nig) % gsz); u.pn = (wgid % nig) / gsz; return true;
    }
    __device__ __forceinline__ void a_ready(const Unit&) const {}
    __device__ __forceinline__ void done(const Unit&) const {}
};

__device__ __forceinline__ unsigned cvt_pk_bf16(float lo, float hi) { unsigned r; asm volatile("v_cvt_pk_bf16_f32 %0, %1, %2" : "=v"(r) : "v"(lo), "v"(hi)); return r; }
typedef float f32x2 __attribute__((ext_vector_type(2)));
__device__ __forceinline__ f32x2 gelu_pk(f32x2 v) {
    const f32x2 av = __builtin_elementwise_abs(v), d = av * 0.2316418882f + 1.0f;
    f32x2 t; t.x = __builtin_amdgcn_rcpf(d.x); t.y = __builtin_amdgcn_rcpf(d.y);
    f32x2 q = t * 0.5307027145f + (-0.7265760135f); q = q * t + 0.7107068705f; q = q * t + (-0.142248368f); q = q * t + 0.127414796f; q = q * t;
    const f32x2 s = (v * v) * (-0.72134752044f);
    f32x2 e; e.x = __builtin_amdgcn_exp2f(s.x); e.y = __builtin_amdgcn_exp2f(s.y);
    const f32x2 m = v * (q * e), r = v - m;
    f32x2 o; o.x = v.x < 0.f ? m.x : r.x; o.y = v.y < 0.f ? m.y : r.y; return o;
}

template <int ACT  > struct EpiBf16 {
    static constexpr bool PERM = true, AFTER_DRAIN = false; static_assert(ACT == 0 || ACT == 1, "EpiBf16: ACT is 0 (none) or 1 (gelu_pk)");
    bf16_t* O; int ldc; const float* bias; int split_cols; size_t split_stride; float scale0;
    __device__ __forceinline__ void operator()(const f32x4 (&acc)[2][2][4][2], const Unit& u, int wr, int wc, int fr, int fq) const {
        const int row0 = u.pm * BM + wr * 64 + fr; int colt = u.pn * BM; bf16_t* base = O;
        float sc = 1.f; if (split_cols) { const int t = colt / split_cols; base += (size_t)t * split_stride; colt -= t * split_cols; if (t == 0) sc = scale0; }
        const int col0 = colt + wc * 32 + 8 * fq, bcol0 = u.pn * BM + wc * 32 + 8 * fq;
        f32x4 bv[2][2];
#pragma unroll
        for (int bj = 0; bj < 2; ++bj)
#pragma unroll
            for (int n = 0; n < 2; ++n) bv[bj][n] = bias ? *(const f32x4*)(bias + bcol0 + bj * HALF + 4 * n) : (f32x4){0.f, 0.f, 0.f, 0.f};
#pragma unroll
        for (int ai = 0; ai < 2; ++ai)
#pragma unroll
            for (int m = 0; m < 4; ++m) { bf16_t* rowp = base + (size_t)(row0 + ai * HALF + m * 16) * ldc + col0;
#pragma unroll
                for (int bj = 0; bj < 2; ++bj) { f32x4 v0 = acc[ai][bj][m][0] + bv[bj][0], v1 = acc[ai][bj][m][1] + bv[bj][1];
                    if (ACT == 1) { f32x2 a = gelu_pk((f32x2){v0[0], v0[1]}), b = gelu_pk((f32x2){v0[2], v0[3]}), c = gelu_pk((f32x2){v1[0], v1[1]}), d = gelu_pk((f32x2){v1[2], v1[3]});
                        v0 = (f32x4){a.x, a.y, b.x, b.y}; v1 = (f32x4){c.x, c.y, d.x, d.y}; }
                    v0 = v0 * sc; v1 = v1 * sc; u32x4 w; w.x = cvt_pk_bf16(v0[0], v0[1]); w.y = cvt_pk_bf16(v0[2], v0[3]); w.z = cvt_pk_bf16(v1[0], v1[1]); w.w = cvt_pk_bf16(v1[2], v1[3]);
                    *(u32x4*)(rowp + bj * HALF) = w; } }
    }
};

template <class Epi, class Sched, bool ALIGN_EPI = false, bool SP2 = false>
__device__ __forceinline__ void gemm_phase(PG8_LAS unsigned char* lds, const Gemm g, const Sched& S, const Epi& E) {
    const int tid = threadIdx.x, wid = __builtin_amdgcn_readfirstlane(tid >> 6), lane = tid & 63, wr = wid >> 2, wc = wid & 3, fr = lane & 15, fq = lane >> 4;
    const int K = g.K, nt = K / BK;
    unsigned voffA[2], voffB[2];
#pragma unroll
    for (int i = 0; i < 2; ++i) { int R, C; stage_rc(tid * 16 + i * 8192, R, C); const int Rb = Epi::PERM ? ((R & ~31) + perm32(R & 31)) : R;
        voffA[i] = (unsigned)(R * g.lda + C) * 2u; voffB[i] = (unsigned)(Rb * g.ldb + C) * 2u; }
    const size_t kstep = (size_t)(BK * 2);
    const size_t hstepA = (size_t)HALF * g.lda * 2, hstepB = (size_t)HALF * g.ldb * 2;
    const size_t tstepA = 2 * hstepA, tstepB = 2 * hstepB;
    const unsigned ldsw = (unsigned)wid * 1024u;
    const int aoff = lds_byte(wr * 64 + fr, fq * 8), boff = lds_byte(wc * 32 + fr, fq * 8);
#define PG8_SA(b, h) (((b) * 2 + (h)) * HTB)
#define PG8_SB(b, h) ((4 + (b) * 2 + (h)) * HTB)
#define PG8_STAGE(bufoff, gbase, voff) do { _Pragma("unroll") for (int _i = 0; _i < 2; ++_i) \
        __builtin_amdgcn_global_load_lds((const unsigned*)((const char*)(gbase) + (voff)[_i]), (PG8_LAS unsigned*)(lds + (bufoff) + ldsw + _i * 8192), 16, 0, 0); } while (0)
#define PG8_LDA(dst, b, h) do { _Pragma("unroll") for (int m = 0; m < 4; ++m) _Pragma("unroll") for (int k = 0; k < 2; ++k) dst[m][k] = *(const PG8_LAS bf16x8*)(lds + PG8_SA(b, h) + aoff + m * 2048 + k * 1024); } while (0)
#define PG8_LDB(dst, b, h) do { _Pragma("unroll") for (int n = 0; n < 2; ++n) _Pragma("unroll") for (int k = 0; k < 2; ++k) dst[n][k] = *(const PG8_LAS bf16x8*)(lds + PG8_SB(b, h) + boff + n * 2048 + k * 1024); } while (0)
#define PG8_MMA(ai, bj, At, Bt) do { __builtin_amdgcn_s_setprio(1); _Pragma("unroll") for (int m = 0; m < 4; ++m) _Pragma("unroll") for (int n = 0; n < 2; ++n) _Pragma("unroll") for (int k = 0; k < 2; ++k) \
        acc[ai][bj][m][n] = __builtin_amdgcn_mfma_f32_16x16x32_bf16(Bt[n][k], At[m][k], acc[ai][bj][m][n], 0, 0, 0); __builtin_amdgcn_s_setprio(0); } while (0)
#define PG8_WAIT_V(n) asm volatile("s_waitcnt vmcnt(" #n ")" ::: "memory")
#define PG8_WAIT_L(n) asm volatile("s_waitcnt lgkmcnt(" #n ")" ::: "memory")
#define PG8_BAR __builtin_amdgcn_s_barrier()
#define PG8_SCHED __builtin_amdgcn_sched_barrier(0)
    Unit cur, nxt; int ui = 0;
    if (!S.next(0, cur)) return;
    f32x4 acc[2][2][4][2];
#pragma unroll
    for (int a = 0; a < 2; ++a)
#pragma unroll
        for (int b = 0; b < 2; ++b)
#pragma unroll
            for (int m = 0; m < 4; ++m)
#pragma unroll
                for (int n = 0; n < 2; ++n) acc[a][b][m][n] = (f32x4){0.f, 0.f, 0.f, 0.f};
    bf16x8 At[4][2], B0[2][2], B1[2][2];
    const char* cA = (const char*)g.A + (size_t)cur.pm * tstepA; const char* cB = (const char*)g.Bt + (size_t)cur.pn * tstepB + S.boff(cur);
    S.a_ready(cur);
    if constexpr (SP2) {
        PG8_STAGE(PG8_SB(0, 0), cB, voffB); PG8_STAGE(PG8_SB(0, 1), cB + hstepB, voffB); PG8_STAGE(PG8_SA(0, 0), cA, voffA); PG8_STAGE(PG8_SA(0, 1), cA + hstepA, voffA);
        if (wr == 1) PG8_BAR;
        PG8_WAIT_V(2); PG8_BAR;
        PG8_STAGE(PG8_SB(1, 0), cB + kstep, voffB); PG8_STAGE(PG8_SA(1, 0), cA + kstep, voffA); PG8_STAGE(PG8_SB(1, 1), cB + hstepB + kstep, voffB);
        PG8_WAIT_V(6); PG8_BAR;
    } else {
        PG8_STAGE(PG8_SB(0, 0), cB, voffB); PG8_STAGE(PG8_SA(0, 0), cA, voffA); PG8_STAGE(PG8_SB(0, 1), cB + hstepB, voffB); PG8_STAGE(PG8_SA(0, 1), cA + hstepA, voffA);
        if (wr == 1) PG8_BAR;
        PG8_WAIT_V(4); PG8_BAR;
        PG8_STAGE(PG8_SB(1, 0), cB + kstep, voffB); PG8_STAGE(PG8_SA(1, 0), cA + kstep, voffA); PG8_STAGE(PG8_SB(1, 1), cB + hstepB + kstep, voffB);
        PG8_WAIT_V(6); PG8_BAR;
    }
    for (;;) {
        const bool has_next = S.next(ui + 1, nxt);
        const char* nA = has_next ? (const char*)g.A + (size_t)nxt.pm * tstepA : cA; const char* nB = has_next ? (const char*)g.Bt + (size_t)nxt.pn * tstepB + S.boff(nxt) : cB;
        for (int t = 0; t < nt; t += 2) {
            const bool last = (t == nt - 2);
            const char* a1 = cA + (size_t)(t + 1) * kstep;
            const char* a2 = last ? nA : cA + (size_t)(t + 2) * kstep; const char* b2 = last ? nB : cB + (size_t)(t + 2) * kstep;
            const char* a3 = a2 + kstep; const char* b3 = b2 + kstep;
            if (last && has_next) S.a_ready(nxt);
            if constexpr (SP2) {
            PG8_LDB(B0, 0, 0); PG8_LDB(B1, 0, 1); PG8_SCHED; PG8_LDA(At, 0, 0); PG8_STAGE(PG8_SA(1, 1), a1 + hstepA, voffA);
            PG8_WAIT_V(8); PG8_WAIT_L(0); PG8_BAR; PG8_MMA(0, 0, At, B0); PG8_MMA(0, 1, At, B1); PG8_BAR; PG8_SCHED;
            PG8_LDA(At, 0, 1); PG8_STAGE(PG8_SB(0, 0), b2, voffB); PG8_STAGE(PG8_SB(0, 1), b2 + hstepB, voffB); PG8_STAGE(PG8_SA(0, 0), a2, voffA);
            PG8_WAIT_V(8); PG8_WAIT_L(0); PG8_BAR; PG8_MMA(1, 0, At, B0); PG8_MMA(1, 1, At, B1); PG8_BAR; PG8_SCHED;
            PG8_LDB(B0, 1, 0); PG8_LDB(B1, 1, 1); PG8_SCHED; PG8_LDA(At, 1, 0); PG8_STAGE(PG8_SA(0, 1), a2 + hstepA, voffA);
            PG8_WAIT_V(8); PG8_WAIT_L(0); PG8_BAR; PG8_MMA(0, 0, At, B0); PG8_MMA(0, 1, At, B1); PG8_BAR; PG8_SCHED;
            PG8_LDA(At, 1, 1); PG8_STAGE(PG8_SB(1, 0), b3, voffB); PG8_STAGE(PG8_SB(1, 1), b3 + hstepB, voffB); PG8_STAGE(PG8_SA(1, 0), a3, voffA);
            PG8_WAIT_V(8); PG8_WAIT_L(0); PG8_BAR; PG8_MMA(1, 0, At, B0); PG8_MMA(1, 1, At, B1); PG8_BAR; PG8_SCHED;
            } else {
            PG8_LDB(B0, 0, 0); PG8_SCHED; PG8_LDA(At, 0, 0); PG8_STAGE(PG8_SA(1, 1), a1 + hstepA, voffA);
            PG8_WAIT_L(8); PG8_BAR; PG8_WAIT_L(0); PG8_MMA(0, 0, At, B0); PG8_BAR; PG8_SCHED;
            PG8_LDB(B1, 0, 1); PG8_STAGE(PG8_SB(0, 0), b2, voffB);
            PG8_BAR; PG8_WAIT_L(0); PG8_MMA(0, 1, At, B1); PG8_BAR;
            PG8_LDA(At, 0, 1); PG8_STAGE(PG8_SA(0, 0), a2, voffA);
            PG8_BAR; PG8_WAIT_L(0); PG8_MMA(1, 0, At, B0); PG8_BAR; PG8_SCHED;
            PG8_STAGE(PG8_SB(0, 1), b2 + hstepB, voffB);
            PG8_WAIT_V(6); PG8_BAR; PG8_MMA(1, 1, At, B1); PG8_BAR;
            PG8_LDB(B0, 1, 0); PG8_SCHED; PG8_LDA(At, 1, 0); PG8_STAGE(PG8_SA(0, 1), a2 + hstepA, voffA);
            PG8_WAIT_L(8); PG8_BAR; PG8_WAIT_L(0); PG8_MMA(0, 0, At, B0); PG8_BAR; PG8_SCHED;
            PG8_LDB(B1, 1, 1); PG8_STAGE(PG8_SB(1, 0), b3, voffB);
            PG8_BAR; PG8_WAIT_L(0); PG8_MMA(0, 1, At, B1); PG8_BAR;
            PG8_LDA(At, 1, 1); PG8_STAGE(PG8_SA(1, 0), a3, voffA);
            PG8_BAR; PG8_WAIT_L(0); PG8_MMA(1, 0, At, B0); PG8_BAR; PG8_SCHED;
            PG8_STAGE(PG8_SB(1, 1), b3 + hstepB, voffB);
            PG8_WAIT_V(6); PG8_BAR; PG8_MMA(1, 1, At, B1); PG8_BAR;
            }
        }
        if constexpr (ALIGN_EPI) { if (wr == 0) PG8_BAR; }
        if constexpr (!Epi::AFTER_DRAIN) { E(acc, cur, wr, wc, fr, fq); S.done(cur); }
        if (!has_next) break;
#pragma unroll
        for (int a = 0; a < 2; ++a)
#pragma unroll
            for (int b = 0; b < 2; ++b)
#pragma unroll
                for (int m = 0; m < 4; ++m)
#pragma unroll
                    for (int n = 0; n < 2; ++n) acc[a][b][m][n] = (f32x4){0.f, 0.f, 0.f, 0.f};
        cur = nxt; cA = nA; cB = nB; ++ui;
        if constexpr (ALIGN_EPI) { if (wr == 1) PG8_BAR; }
    }
    PG8_WAIT_V(0);
    if constexpr (!ALIGN_EPI) { if (wr == 0) PG8_BAR; }
    PG8_BAR;
    if constexpr (Epi::AFTER_DRAIN) { E.fused(acc, cur, wr, wc, fr, fq, lds, wid, lane); S.done(cur); }
#undef PG8_SA
#undef PG8_SB
#undef PG8_STAGE
#undef PG8_LDA
#undef PG8_LDB
#undef PG8_MMA
#undef PG8_WAIT_V
#undef PG8_WAIT_L
#undef PG8_BAR
#undef PG8_SCHED
}
}

#define GAS __attribute__((address_space(1)))
#define LAS __attribute__((address_space(3)))
#define DEV __device__ __forceinline__
typedef unsigned short bf16;
typedef unsigned v4u __attribute__((ext_vector_type(4)));
typedef unsigned v2u __attribute__((ext_vector_type(2)));
typedef float f32x4 __attribute__((ext_vector_type(4)));
typedef GAS unsigned gu32;
#define RLX_AGENT __ATOMIC_RELAXED, __HIP_MEMORY_SCOPE_AGENT
#define LDS_WAIT() asm volatile("s_waitcnt lgkmcnt(0)" ::: "memory")
#define VM_WAIT() asm volatile("s_waitcnt vmcnt(0)" ::: "memory")

constexpr int NB = 4, SEQ = 4096, T = NB * SEQ, D = 2048;
constexpr int NH = 8, DK = 64, DV = 128, AW = 1024, LW = 1024;
constexpr int INC = 9216;
constexpr int C_Q = 0, C_K = 1024, C_V = 2048, C_XL = 3072, C_GL = 4096, C_GT = 5120;
constexpr int NE = 32, TOPK = 4, HID = 4096, FF = 2048;
constexpr int MAXTILES = 288, PMAX = MAXTILES * 256;
constexpr float RMS_EPS = 1e-6f;
constexpr int NWAVES = 8, NTHR = 512;

constexpr size_t MiB = (size_t)1 << 20;
constexpr size_t WS_CTL = 0, CTL_ZERO_BYTES = 1 * MiB;
constexpr size_t WS_WIN = 2 * MiB, WS_WA = 38 * MiB, WS_WB = 42 * MiB, WS_WOUT = 46 * MiB;
constexpr size_t WS_ROUTE = 54 * MiB;
constexpr size_t WS_W1 = 64 * MiB, WS_W2 = 576 * MiB;
constexpr size_t WS_H = 832 * MiB, WS_PROJ = 896 * MiB, WS_Q = 1184 * MiB, WS_K = 1216 * MiB, WS_OAB = 1248 * MiB;
constexpr size_t WS_LA = 1312 * MiB, WS_LU = 1376 * MiB, WS_YA = 1440 * MiB, WS_YB = 1504 * MiB, WS_MIX = 1568 * MiB, WS_H2 = 1632 * MiB;
constexpr size_t WS_XG = 1696 * MiB, WS_ACT = 1984 * MiB, WS_EO = 2272 * MiB, WS_END = 2560 * MiB;
constexpr int CW_TMO = 0, CW_CODE = 1, CW_CNT = 64, CW_BAR = 4096;

constexpr int RING_OFF = 0, RING_BYTES = 131072;
constexpr int LDSCTL_OFF = RING_BYTES;
constexpr int MISC_OFF = LDSCTL_OFF;
constexpr int TEXP_OFF = LDSCTL_OFF + 256;
constexpr int PADS_OFF = TEXP_OFF + 1280;
constexpr int CNTL_OFF = PADS_OFF + 256;
constexpr int NMT_OFF = CNTL_OFF + 256;
constexpr int LDS_BYTES = 147456;
static_assert(NMT_OFF + 64 <= LDS_BYTES, "LDS map");

DEV float bf2f(unsigned v) { return __uint_as_float(v << 16); }
DEV unsigned f2bf(float f) { unsigned u = __builtin_bit_cast(unsigned, f); return (u + 0x7fffu + ((u >> 16) & 1u)) >> 16; }
DEV unsigned pk2(float lo, float hi) { return f2bf(lo) | (f2bf(hi) << 16); }
DEV float wave_sum(float v) {
#pragma unroll
    for (int o = 1; o < 64; o <<= 1) v += __shfl_xor(v, o);
    return v;
}
DEV float wave_max(float v) {
#pragma unroll
    for (int o = 1; o < 64; o <<= 1) v = fmaxf(v, __shfl_xor(v, o));
    return v;
}
DEV float sigmoidf_(float x) { return 1.0f / (1.0f + __expf(-x)); }
DEV float gelu_tanh(float x) { const float u = 0.7978845608028654f * (x + 0.044715f * x * x * x); return 0.5f * x * (1.0f + tanhf(u)); }

DEV int t5_bucket(int rel) {
    const int ret = rel > 0 ? 16 : 0; const int n = rel < 0 ? -rel : rel;
    int v;
    if (n < 8) v = n;
    else if (n >= 128) v = 15;
    else { const int l2 = 31 - __builtin_clz((unsigned)(n * n)); int lg = 8 + (l2 - 6); v = lg < 15 ? lg : 15; }
    return ret + v;
}

#define XB_TMO      128
#define XB_XCNT(j)  (256  + 64 * (j))
#define XB_XSUB(j)  (1280 + 64 * (j))
#define XB_XGEN(j)  (2304 + 64 * (j))
#define XB_TOP      3328
#define XB_TOPGEN   3392
#define XCD_BAR_WORDS 3456
#define XB_SPIN_CAP (1u << 18)
DEV unsigned xb_ld(unsigned* p)              { return __hip_atomic_load(p, __ATOMIC_RELAXED, __HIP_MEMORY_SCOPE_AGENT); }
DEV unsigned xb_add(unsigned* p, unsigned v) { return __hip_atomic_fetch_add(p, v, __ATOMIC_RELAXED, __HIP_MEMORY_SCOPE_AGENT); }
DEV unsigned xb_xcc_id() { return (unsigned)__builtin_amdgcn_s_getreg((3 << 11) | 20) & 0xFu; }
#define XB_SPIN(cond, bar) do { unsigned _sp = 0; while (cond) { __builtin_amdgcn_s_sleep(1); \
    if ((++_sp & 255u) == 0u) { if (xb_ld(&(bar)[XB_TMO])) break; if (_sp > XB_SPIN_CAP) { atomicAdd(&(bar)[XB_TMO], 1u); break; } } } } while (0)
struct XcdBarrier { unsigned* bar; unsigned x; volatile LAS unsigned* st; };
DEV XcdBarrier xcd_barrier_post(unsigned* bar, volatile LAS unsigned* st) {
    XcdBarrier b; b.bar = bar; b.x = xb_xcc_id(); b.st = st;
    if (threadIdx.x == 0) (void)xb_add(&bar[XB_XCNT(b.x)], 1u);
    return b;
}
DEV void xcd_barrier_complete(unsigned* bar, unsigned x, unsigned& nloc, unsigned& nx) {
    const unsigned G = gridDim.x * gridDim.y * gridDim.z;
    unsigned sum, cnt, mine, sp = 0u;
    for (;;) {
        sum = 0u; cnt = 0u; mine = 0u;
#pragma unroll
        for (unsigned j = 0; j < 16; ++j) { const unsigned c = xb_ld(&bar[XB_XCNT(j)]); sum += c; cnt += (c > 0u) ? 1u : 0u; mine = (j == x) ? c : mine; }
        if (sum == G) break;
        __builtin_amdgcn_s_sleep(1);
        if ((++sp & 255u) == 0u) { if (xb_ld(&bar[XB_TMO])) break; if (sp > XB_SPIN_CAP) { atomicAdd(&bar[XB_TMO], 1u); break; } }
    }
    nloc = mine > 0u ? mine : 1u; nx = cnt > 0u ? cnt : 1u;
}
DEV void xcd_barrier(const XcdBarrier& b) {
    asm volatile("s_waitcnt vmcnt(0)" ::: "memory");
    __syncthreads();
    if (threadIdx.x == 0) {
        unsigned* bar = b.bar;
        __builtin_amdgcn_s_waitcnt(0);
        unsigned nloc = b.st[0], nx = b.st[1];
        if (nloc == 0u) { xcd_barrier_complete(bar, b.x, nloc, nx); b.st[0] = nloc; b.st[1] = nx; }
        const unsigned old = xb_add(&bar[XB_XSUB(b.x)], 1u);
        const unsigned gen = old / nloc;
        if (old + 1u == (gen + 1u) * nloc) {
            __builtin_amdgcn_fence(__ATOMIC_RELEASE, "agent");
            asm volatile("s_waitcnt vmcnt(0)" ::: "memory");
            const unsigned og = xb_add(&bar[XB_TOP], 1u);
            const unsigned tg = og / nx;
            if (og + 1u == (tg + 1u) * nx) xb_add(&bar[XB_TOPGEN], 1u);
            else XB_SPIN(xb_ld(&bar[XB_TOPGEN]) == tg, bar);
            __builtin_amdgcn_fence(__ATOMIC_ACQUIRE, "agent");
            xb_add(&bar[XB_XGEN(b.x)], 1u);
            asm volatile("s_waitcnt vmcnt(0)" ::: "memory");
        } else {
            XB_SPIN(xb_ld(&bar[XB_XGEN(b.x)]) == gen, bar);
            __builtin_amdgcn_fence(__ATOMIC_ACQUIRE, "agent");
            asm volatile("s_waitcnt vmcnt(0)" ::: "memory");
        }
    }
    __syncthreads();
}

namespace pg8 {
struct EpiF32Res {
    static constexpr bool PERM = false, AFTER_DRAIN = false;
    float* C; int ldc; const float* res;
    __device__ __forceinline__ void operator()(const f32x4 (&acc)[2][2][4][2], const Unit& u, int wr, int wc, int fr, int fq) const {
        const int row0 = u.pm * BM + wr * 64 + fr, col0 = u.pn * BM + wc * 32 + 4 * fq;
#pragma unroll
        for (int ai = 0; ai < 2; ++ai)
#pragma unroll
            for (int m = 0; m < 4; ++m) { const size_t off = (size_t)(row0 + ai * HALF + m * 16) * ldc + col0;
#pragma unroll
                for (int bj = 0; bj < 2; ++bj)
#pragma unroll
                    for (int n = 0; n < 2; ++n) { const f32x4 r = *(const f32x4*)(res + off + bj * HALF + n * 16); *(f32x4*)(C + off + bj * HALF + n * 16) = acc[ai][bj][m][n] + r; } }
    }
};
struct EpiSwiglu {
    static constexpr bool PERM = true, AFTER_DRAIN = false;
    bf16_t* O; const float* b1; const PG8_LAS int* texp;
    static __device__ __forceinline__ float sw(float g, float l) { g = fminf(g, 7.0f); l = fminf(fmaxf(l, -7.0f), 7.0f); return g * (1.0f / (1.0f + __expf(-1.702f * g))) * (l + 1.0f); }
    __device__ __forceinline__ void operator()(const f32x4 (&acc)[2][2][4][2], const Unit& u, int wr, int wc, int fr, int fq) const {
        const int e = texp[u.pm]; const float* bias = b1 + (size_t)e * 4096;
        const int row0 = u.pm * BM + wr * 64 + fr, col0 = u.pn * BM + wc * 32 + 8 * fq;
        f32x4 bv[2][2];
#pragma unroll
        for (int bj = 0; bj < 2; ++bj)
#pragma unroll
            for (int n = 0; n < 2; ++n) bv[bj][n] = *(const f32x4*)(bias + col0 + bj * HALF + 4 * n);
#pragma unroll
        for (int ai = 0; ai < 2; ++ai)
#pragma unroll
            for (int m = 0; m < 4; ++m) { bf16_t* rowp = O + (size_t)(row0 + ai * HALF + m * 16) * 2048 + (col0 >> 1);
#pragma unroll
                for (int bj = 0; bj < 2; ++bj) { const f32x4 v0 = acc[ai][bj][m][0] + bv[bj][0], v1 = acc[ai][bj][m][1] + bv[bj][1];
                    typedef unsigned u32x2 __attribute__((ext_vector_type(2)));
                    u32x2 w; w.x = cvt_pk_bf16(sw(v0[0], v0[1]), sw(v0[2], v0[3])); w.y = cvt_pk_bf16(sw(v1[0], v1[1]), sw(v1[2], v1[3]));
                    *(u32x2*)(rowp + bj * 64) = w; } }
    }
};
struct EpiEo {
    static constexpr bool PERM = true, AFTER_DRAIN = false;
    bf16_t* O; const float* b2; const PG8_LAS int* texp;
    __device__ __forceinline__ void operator()(const f32x4 (&acc)[2][2][4][2], const Unit& u, int wr, int wc, int fr, int fq) const {
        const int e = texp[u.pm]; const float* bias = b2 + (size_t)e * 2048;
        const int row0 = u.pm * BM + wr * 64 + fr, col0 = u.pn * BM + wc * 32 + 8 * fq;
        f32x4 bv[2][2];
#pragma unroll
        for (int bj = 0; bj < 2; ++bj)
#pragma unroll
            for (int n = 0; n < 2; ++n) bv[bj][n] = *(const f32x4*)(bias + col0 + bj * HALF + 4 * n);
#pragma unroll
        for (int ai = 0; ai < 2; ++ai)
#pragma unroll
            for (int m = 0; m < 4; ++m) { bf16_t* rowp = O + (size_t)(row0 + ai * HALF + m * 16) * 2048 + col0;
#pragma unroll
                for (int bj = 0; bj < 2; ++bj) { const f32x4 v0 = acc[ai][bj][m][0] + bv[bj][0], v1 = acc[ai][bj][m][1] + bv[bj][1];
                    u32x4 w; w.x = cvt_pk_bf16(v0[0], v0[1]); w.y = cvt_pk_bf16(v0[2], v0[3]); w.z = cvt_pk_bf16(v1[0], v1[1]); w.w = cvt_pk_bf16(v1[2], v1[3]);
                    *(u32x4*)(rowp + bj * HALF) = w; } }
    }
};
}

DEV void p0_transpose_item(const float* W, int K, int N, bf16* WT, LAS float* scr, int item, int lane) {
    const int nblk = N / 32, kb = item / nblk, nb = item % nblk, k0 = 64 * kb, n0 = 32 * nb;
#pragma unroll 8
    for (int i = 0; i < 32; ++i) { const int kk = 2 * i + (lane >> 5); scr[kk * 33 + (lane & 31)] = W[(size_t)(k0 + kk) * N + n0 + (lane & 31)]; }
    LDS_WAIT(); asm volatile("" ::: "memory");
    const int c = lane & 7;
#pragma unroll
    for (int j = 0; j < 4; ++j) { const int n = (lane >> 3) + 8 * j; const LAS float* s = scr + (8 * c) * 33 + n;
        v4u o; o.x = pk2(s[0 * 33], s[1 * 33]); o.y = pk2(s[2 * 33], s[3 * 33]); o.z = pk2(s[4 * 33], s[5 * 33]); o.w = pk2(s[6 * 33], s[7 * 33]);
        *(GAS v4u*)(WT + (size_t)(n0 + n) * K + k0 + 8 * c) = o; }
    LDS_WAIT(); asm volatile("" ::: "memory");
}
DEV void rms_row_to_bf16(const float* xrow, const float* gain, bf16* orow, int lane) {
    const GAS f32x4* xr = (const GAS f32x4*)xrow + lane; const GAS f32x4* gr = (const GAS f32x4*)gain + lane;
    f32x4 v[8]; float s = 0.f;
#pragma unroll
    for (int j = 0; j < 8; ++j) { v[j] = xr[64 * j]; s += (v[j].x * v[j].x + v[j].y * v[j].y) + (v[j].z * v[j].z + v[j].w * v[j].w); }
    const float rstd = 1.0f / sqrtf(wave_sum(s) * (1.f / D) + RMS_EPS);
    GAS v2u* o8 = (GAS v2u*)orow + lane;
#pragma unroll
    for (int j = 0; j < 8; ++j) { const f32x4 g = gr[64 * j]; v2u o; o.x = pk2(v[j].x * rstd * g.x, v[j].y * rstd * g.y); o.y = pk2(v[j].z * rstd * g.z, v[j].w * rstd * g.w); o8[64 * j] = o; }
}

struct Args { const float* in[29]; float* out; unsigned char* ws; int ph_lo, ph_hi; };
constexpr int NPHASE = 15;

DEV void moe_tiles(const unsigned* cnt_g, LAS unsigned char* lds, int tid) {
    LAS int* texp = (LAS int*)(lds + TEXP_OFF); LAS int* pads = (LAS int*)(lds + PADS_OFF); LAS int* cl = (LAS int*)(lds + CNTL_OFF); LAS int* nmt = (LAS int*)(lds + NMT_OFF);
    __syncthreads();
    if (tid < 32) cl[tid] = (int)__hip_atomic_load(cnt_g + tid, RLX_AGENT);
    __syncthreads();
    if (tid == 0) {
        int nt = 0;
        for (int e = 0; e < NE; ++e) { const int c = cl[e]; const int ntile = (c + 255) >> 8; pads[e] = nt * 256; for (int i = 0; i < ntile; ++i) texp[nt + i] = e; nt += ntile; }
        pads[NE] = nt * 256; nmt[0] = nt;
    }
    __syncthreads();
}

__global__ void __launch_bounds__(NTHR, 2) fwd_kernel(Args args) {
    extern __shared__ __attribute__((aligned(16))) unsigned char lds_raw[];
    LAS unsigned char* lds = (LAS unsigned char*)lds_raw;
    const int tid = threadIdx.x, lane = tid & 63, wave = __builtin_amdgcn_readfirstlane(tid >> 6);
    const int G = gridDim.x, bx = blockIdx.x;
    const int gw = bx * NWAVES + wave, NGW = G * NWAVES;
    const int gt = bx * NTHR + tid, NGT = G * NTHR;
    unsigned char* ws = args.ws;
    gu32* ctl = (gu32*)(ws + WS_CTL);
    for (int u = tid; u < (LDS_BYTES - LDSCTL_OFF) / 4; u += NTHR) ((LAS unsigned*)(lds + LDSCTL_OFF))[u] = 0u;
    __syncthreads();
    XcdBarrier bar = xcd_barrier_post((unsigned*)ctl + CW_BAR, (volatile LAS unsigned*)(lds + MISC_OFF));
    const int lo = args.ph_lo, hi = args.ph_hi;
#ifndef PHMASK
#define PHMASK 0x7fff
#endif
#define IN(k) ((((PHMASK) >> (k)) & 1) && lo <= (k) && (k) < hi)
#define SEAM(k) do { if (IN(k) && IN((k) + 1)) xcd_barrier(bar); } while (0)

    const float* x = args.in[0];
    bf16* WIN_T = (bf16*)(ws + WS_WIN); bf16* WA_T = (bf16*)(ws + WS_WA); bf16* WB_T = (bf16*)(ws + WS_WB); bf16* WOUT_T = (bf16*)(ws + WS_WOUT);
    bf16* W1_T = (bf16*)(ws + WS_W1); bf16* W2_T = (bf16*)(ws + WS_W2);
    bf16* Hb = (bf16*)(ws + WS_H); bf16* PROJ = (bf16*)(ws + WS_PROJ); bf16* Qb = (bf16*)(ws + WS_Q); bf16* Kb = (bf16*)(ws + WS_K); bf16* OAB = (bf16*)(ws + WS_OAB);
    float* LA = (float*)(ws + WS_LA); float* LU = (float*)(ws + WS_LU);
    bf16* YA = (bf16*)(ws + WS_YA); bf16* YB = (bf16*)(ws + WS_YB); bf16* MIX = (bf16*)(ws + WS_MIX); bf16* H2 = (bf16*)(ws + WS_H2);
    bf16* XG = (bf16*)(ws + WS_XG); bf16* ACT = (bf16*)(ws + WS_ACT); bf16* EO = (bf16*)(ws + WS_EO);
    int* route_e = (int*)(ws + WS_ROUTE); int* route_rank = route_e + T * TOPK; float* route_gate = (float*)(route_rank + T * TOPK); int* tok_by_e = (int*)(route_gate + T * TOPK);
    unsigned* cnt_g = (unsigned*)ctl + CW_CNT;
    float* out = args.out;

    if (IN(0)) {
        LAS float* scr = (LAS float*)(lds + RING_OFF + wave * 16384);
        constexpr int I_IN = (D / 64) * (INC / 32), I_A = (AW / 64) * (D / 32), I_O = (D / 64) * (D / 32), I_1 = (D / 64) * (HID / 32), I_2 = (FF / 64) * (D / 32);
        constexpr int NITEMS = I_IN + 2 * I_A + I_O + NE * I_1 + NE * I_2;
        for (int it = gw; it < NITEMS; it += NGW) {
            int r = it;
            if (r < I_IN) { p0_transpose_item(args.in[2], D, INC, WIN_T, scr, r, lane); continue; } r -= I_IN;
            if (r < I_A) { p0_transpose_item(args.in[19], AW, D, WA_T, scr, r, lane); continue; } r -= I_A;
            if (r < I_A) { p0_transpose_item(args.in[20], LW, D, WB_T, scr, r, lane); continue; } r -= I_A;
            if (r < I_O) { p0_transpose_item(args.in[21], D, D, WOUT_T, scr, r, lane); continue; } r -= I_O;
            if (r < NE * I_1) { const int e = r / I_1; p0_transpose_item(args.in[25] + (size_t)e * D * HID, D, HID, W1_T + (size_t)e * HID * D, scr, r % I_1, lane); continue; } r -= NE * I_1;
            { const int e = r / I_2; p0_transpose_item(args.in[27] + (size_t)e * FF * D, FF, D, W2_T + (size_t)e * D * FF, scr, r % I_2, lane); }
        }
        for (int m = gw; m < T; m += NGW) rms_row_to_bf16(x + (size_t)m * D, args.in[1], Hb + (size_t)m * D, lane);
    }
    SEAM(0);
    if (IN(1)) {
        pg8::Gemm g{Hb, WIN_T, T, INC, D, D, D}; pg8::StaticOrder S; S.init(T, INC, G, bx);
        pg8::EpiBf16<0> E{PROJ, INC, nullptr, 0, 0, 1.f};
        pg8::gemm_phase<pg8::EpiBf16<0>, pg8::StaticOrder, true, true>(lds + RING_OFF, g, S, E);
    }
    SEAM(1);
    if (IN(2)) {
        for (int idx = gt; idx < T * 32; idx += NGT) {
            const int t = idx >> 5, gi = idx & 31, isk = gi >> 4, gj = gi & 15;
            const bf16* src = PROJ + (size_t)t * INC + (isk ? C_K : C_Q) + gj * 64;
            float ss = 0.f;
            for (int d = 0; d < 64; ++d) { const float v = bf2f(src[d]); ss += v * v; }
            const float rstd = 1.0f / sqrtf(ss * (1.f / 64.f) + RMS_EPS);
            const float* gain = isk ? args.in[5] : args.in[4]; const float sc = isk ? 1.0f : 0.125f;
            bf16* dst = (isk ? Kb : Qb) + (size_t)t * 1024 + gj * 64;
            for (int d = 0; d < 64; ++d) dst[d] = (bf16)f2bf(bf2f(src[d]) * rstd * gain[d] * sc);
        }
    }
    SEAM(2);
    if (IN(3)) {
        LAS float* qs = (LAS float*)(lds + RING_OFF + wave * 1024);
        LAS float* dsh = qs + 128;
        float lam;
        { const float a = wave_sum(args.in[6][lane] * args.in[7][lane]), b = wave_sum(args.in[8][lane] * args.in[9][lane]); lam = __expf(a) - __expf(b) + 0.2f; }
        const float* table = args.in[11];
        for (int u = gw; u < T * NH; u += NGW) {
            const int t = u >> 3, h = u & 7, b = t >> 12, qpos = t & 4095, nk = ((qpos >> 6) + 1) * 64;
            LDS_WAIT(); asm volatile("" ::: "memory");
            qs[lane] = bf2f(Qb[(size_t)t * 1024 + h * 128 + lane]); qs[64 + lane] = bf2f(Qb[(size_t)t * 1024 + h * 128 + 64 + lane]);
            LDS_WAIT(); asm volatile("" ::: "memory");
            float m0 = -1e30f, l0 = 0.f, m1 = -1e30f, l1 = 0.f;
            for (int k0 = 0; k0 < nk; k0 += 64) {
                const int k = k0 + lane; const bf16* kr = Kb + (size_t)(b * SEQ + k) * 1024 + h * 128;
                float s0 = 0.f, s1 = 0.f;
                { const GAS v4u* kr4 = (const GAS v4u*)kr;
#pragma unroll
                  for (int c = 0; c < 8; ++c) { const v4u w0 = kr4[c], w1 = kr4[8 + c]; const LAS f32x4* qa = (const LAS f32x4*)(qs + 8 * c); const LAS f32x4* qb = (const LAS f32x4*)(qs + 64 + 8 * c);
                    const f32x4 a0 = qa[0], a1 = qa[1], b0 = qb[0], b1 = qb[1];
                    s0 += a0.x * bf2f(w0.x & 0xffffu) + a0.y * bf2f(w0.x >> 16) + a0.z * bf2f(w0.y & 0xffffu) + a0.w * bf2f(w0.y >> 16) + a1.x * bf2f(w0.z & 0xffffu) + a1.y * bf2f(w0.z >> 16) + a1.z * bf2f(w0.w & 0xffffu) + a1.w * bf2f(w0.w >> 16);
                    s1 += b0.x * bf2f(w1.x & 0xffffu) + b0.y * bf2f(w1.x >> 16) + b0.z * bf2f(w1.y & 0xffffu) + b0.w * bf2f(w1.y >> 16) + b1.x * bf2f(w1.z & 0xffffu) + b1.y * bf2f(w1.z >> 16) + b1.z * bf2f(w1.w & 0xffffu) + b1.w * bf2f(w1.w >> 16); } }
                const float bias = table[t5_bucket(k - qpos) * 8 + h]; s0 += bias; s1 += bias;
                { const float mn = fmaxf(m0, s0); l0 = l0 * __expf(m0 - mn) + __expf(s0 - mn); m0 = mn; }
                { const float mn = fmaxf(m1, s1); l1 = l1 * __expf(m1 - mn) + __expf(s1 - mn); m1 = mn; }
            }
            const float M0 = wave_max(m0), M1 = wave_max(m1);
            const float L0 = wave_sum(l0 * __expf(m0 - M0)), L1 = wave_sum(l1 * __expf(m1 - M1));
            const float i0 = 1.0f / L0, i1 = lam / L1;
            float o0 = 0.f, o1 = 0.f;
            for (int k0 = 0; k0 < nk; k0 += 64) {
                const int k = k0 + lane; const bf16* kr = Kb + (size_t)(b * SEQ + k) * 1024 + h * 128;
                float s0 = 0.f, s1 = 0.f;
                { const GAS v4u* kr4 = (const GAS v4u*)kr;
#pragma unroll
                  for (int c = 0; c < 8; ++c) { const v4u w0 = kr4[c], w1 = kr4[8 + c]; const LAS f32x4* qa = (const LAS f32x4*)(qs + 8 * c); const LAS f32x4* qb = (const LAS f32x4*)(qs + 64 + 8 * c);
                    const f32x4 a0 = qa[0], a1 = qa[1], b0 = qb[0], b1 = qb[1];
                    s0 += a0.x * bf2f(w0.x & 0xffffu) + a0.y * bf2f(w0.x >> 16) + a0.z * bf2f(w0.y & 0xffffu) + a0.w * bf2f(w0.y >> 16) + a1.x * bf2f(w0.z & 0xffffu) + a1.y * bf2f(w0.z >> 16) + a1.z * bf2f(w0.w & 0xffffu) + a1.w * bf2f(w0.w >> 16);
                    s1 += b0.x * bf2f(w1.x & 0xffffu) + b0.y * bf2f(w1.x >> 16) + b0.z * bf2f(w1.y & 0xffffu) + b0.w * bf2f(w1.y >> 16) + b1.x * bf2f(w1.z & 0xffffu) + b1.y * bf2f(w1.z >> 16) + b1.z * bf2f(w1.w & 0xffffu) + b1.w * bf2f(w1.w >> 16); } }
                const float bias = table[t5_bucket(k - qpos) * 8 + h]; s0 += bias; s1 += bias;
                const float dk = __expf(s0 - M0) * i0 - __expf(s1 - M1) * i1;
                LDS_WAIT(); asm volatile("" ::: "memory");
                dsh[lane] = dk;
                LDS_WAIT(); asm volatile("" ::: "memory");
                const bf16* vr = PROJ + (size_t)(b * SEQ + k0) * INC + C_V + h * 128;
                for (int kk = 0; kk < 64; ++kk) { const float dv = dsh[kk]; o0 += dv * bf2f(vr[(size_t)kk * INC + lane]); o1 += dv * bf2f(vr[(size_t)kk * INC + 64 + lane]); }
            }
            const float ss = wave_sum(o0 * o0 + o1 * o1) * (1.f / 128.f);
            const float rstd = 1.0f / sqrtf(ss + RMS_EPS);
            const float* sg = args.in[10];
            OAB[(size_t)t * 2048 + h * 128 + lane] = (bf16)f2bf(o0 * rstd * sg[lane] * 0.8f);
            OAB[(size_t)t * 2048 + h * 128 + 64 + lane] = (bf16)f2bf(o1 * rstd * sg[64 + lane] * 0.8f);
        }
    }
    SEAM(3);
    if (IN(4)) {
        const float* cw = args.in[12]; const float* cb = args.in[13]; const float* wa = args.in[14]; const float* ba = args.in[15]; const float* wx = args.in[16]; const float* bxv = args.in[17]; const float* lamp = args.in[18];
        for (int idx = gt; idx < T * LW; idx += NGT) {
            const int t = idx >> 10, c = idx & 1023, g = c >> 7, j = c & 127, tb = t & 4095;
            float accr = 0.f, acci = 0.f, xrc = 0.f;
            for (int i = 0; i < 128; ++i) {
                const int ci = g * 128 + i; float xr = cb[ci];
#pragma unroll
                for (int jj = 0; jj < 4; ++jj) { const int dt = jj - 3; if (tb + dt >= 0) xr += cw[jj * 1024 + ci] * bf2f(PROJ[(size_t)(t + dt) * INC + C_XL + ci]); }
                accr += xr * wa[(size_t)(g * 128 + i) * 128 + j]; acci += xr * wx[(size_t)(g * 128 + i) * 128 + j];
                if (i == j) xrc = xr;
            }
            const float r = sigmoidf_(accr + ba[c]), ig = sigmoidf_(acci + bxv[c]);
            const float z = -lamp[c]; const float sp = fmaxf(z, 0.f) + log1pf(__expf(-fabsf(z)));
            const float log_a = -8.0f * r * sp; const float a = __expf(log_a); const float mult = sqrtf(fmaxf(-expm1f(2.0f * log_a), 0.f));
            LA[idx] = a; LU[idx] = mult * ig * xrc;
        }
    }
    SEAM(4);
    if (IN(5)) {
        for (int idx = gt; idx < NB * LW; idx += NGT) {
            const int b = idx >> 10, c = idx & 1023; float hstate = 0.f;
            for (int s = 0; s < SEQ; ++s) { const size_t t = (size_t)b * SEQ + s; hstate = LA[t * LW + c] * hstate + LU[t * LW + c];
                const float gl = bf2f(PROJ[t * INC + C_GL + c]); OAB[t * 2048 + 1024 + c] = (bf16)f2bf(hstate * gelu_tanh(gl)); }
        }
    }
    SEAM(5);
    if (IN(6)) {
        pg8::Gemm g{OAB, WA_T, T, D, AW, 2048, AW}; pg8::StaticOrder S; S.init(T, D, G, bx);
        pg8::EpiBf16<0> E{YA, D, nullptr, 0, 0, 1.f};
        pg8::gemm_phase<pg8::EpiBf16<0>, pg8::StaticOrder, true, true>(lds + RING_OFF, g, S, E);
    }
    SEAM(6);
    if (IN(7)) {
        pg8::Gemm g{OAB + 1024, WB_T, T, D, LW, 2048, LW}; pg8::StaticOrder S; S.init(T, D, G, bx);
        pg8::EpiBf16<0> E{YB, D, nullptr, 0, 0, 1.f};
        pg8::gemm_phase<pg8::EpiBf16<0>, pg8::StaticOrder, true, true>(lds + RING_OFF, g, S, E);
    }
    SEAM(7);
    if (IN(8)) {
        const float* bg = args.in[3];
        for (int idx = gt; idx < T * D; idx += NGT) {
            const int t = idx >> 11, d = idx & 2047;
            const float g0 = sigmoidf_(bf2f(PROJ[(size_t)t * INC + C_GT + d]) + bg[d]), g1 = sigmoidf_(bf2f(PROJ[(size_t)t * INC + C_GT + 2048 + d]) + bg[2048 + d]);
            MIX[idx] = (bf16)f2bf(g0 * bf2f(YA[idx]) + g1 * bf2f(YB[idx]));
        }
    }
    SEAM(8);
    if (IN(9)) {
        pg8::Gemm g{MIX, WOUT_T, T, D, D, D, D}; pg8::StaticOrder S; S.init(T, D, G, bx);
        pg8::EpiF32Res E{out, D, x};
        pg8::gemm_phase<pg8::EpiF32Res, pg8::StaticOrder, true, true>(lds + RING_OFF, g, S, E);
    }
    SEAM(9);
    if (IN(10)) {
        const float* lnf = args.in[22]; const float* wr = args.in[23]; const float* br = args.in[24];
        for (int t = gw; t < T; t += NGW) {
            const GAS f32x4* xr = (const GAS f32x4*)(out + (size_t)t * D) + lane; const GAS f32x4* gr = (const GAS f32x4*)lnf + lane;
            float s = 0.f;
#pragma unroll
            for (int j = 0; j < 8; ++j) { const f32x4 vv = xr[64 * j]; s += (vv.x * vv.x + vv.y * vv.y) + (vv.z * vv.z + vv.w * vv.w); }
            const float rstd = 1.0f / sqrtf(wave_sum(s) * (1.f / D) + RMS_EPS);
            float part[32];
#pragma unroll
            for (int e = 0; e < 32; ++e) part[e] = 0.f;
            GAS v2u* o8 = (GAS v2u*)(H2 + (size_t)t * D) + lane;
#pragma unroll 1
            for (int j = 0; j < 8; ++j) {
                const f32x4 vv = xr[64 * j]; const f32x4 g = gr[64 * j]; f32x4 hv; hv.x = vv.x * rstd * g.x; hv.y = vv.y * rstd * g.y; hv.z = vv.z * rstd * g.z; hv.w = vv.w * rstd * g.w;
                v2u o; o.x = pk2(hv.x, hv.y); o.y = pk2(hv.z, hv.w); o8[64 * j] = o;
                const int d0 = 4 * (lane + 64 * j);
#pragma unroll
                for (int q = 0; q < 4; ++q) { const float hq = q == 0 ? hv.x : q == 1 ? hv.y : q == 2 ? hv.z : hv.w; const GAS f32x4* wrow = (const GAS f32x4*)(wr + (size_t)(d0 + q) * 32);
#pragma unroll
                    for (int e4 = 0; e4 < 8; ++e4) { const f32x4 w = wrow[e4]; part[4 * e4] += hq * w.x; part[4 * e4 + 1] += hq * w.y; part[4 * e4 + 2] += hq * w.z; part[4 * e4 + 3] += hq * w.w; } }
            }
#pragma unroll
            for (int e = 0; e < 32; ++e) part[e] = wave_sum(part[e]) + br[e];
            unsigned taken = 0u; float val[4]; int sel[4];
#pragma unroll
            for (int k = 0; k < 4; ++k) { float best = -3.0e38f; int bi = 0;
#pragma unroll
                for (int e = 0; e < 32; ++e) { const bool ok = !((taken >> e) & 1u) && part[e] > best; best = ok ? part[e] : best; bi = ok ? e : bi; }
                taken |= 1u << bi; val[k] = best; sel[k] = bi; }
            const float w0 = 1.0f, w1 = __expf(val[1] - val[0]), w2 = __expf(val[2] - val[0]), w3 = __expf(val[3] - val[0]); const float inv = 1.0f / (w0 + w1 + w2 + w3);
            if (lane < 4) {
                const int e = lane == 0 ? sel[0] : lane == 1 ? sel[1] : lane == 2 ? sel[2] : sel[3];
                const float gt_ = (lane == 0 ? w0 : lane == 1 ? w1 : lane == 2 ? w2 : w3) * inv;
                const unsigned rank = __hip_atomic_fetch_add(cnt_g + e, 1u, RLX_AGENT);
                tok_by_e[(size_t)e * T + rank] = t; route_e[t * 4 + lane] = e; route_rank[t * 4 + lane] = (int)rank; route_gate[t * 4 + lane] = gt_;
            }
        }
    }
    SEAM(10);
    if (IN(11)) {
        moe_tiles(cnt_g, lds, tid);
        const LAS int* texp = (const LAS int*)(lds + TEXP_OFF); const LAS int* pads = (const LAS int*)(lds + PADS_OFF); const LAS int* cl = (const LAS int*)(lds + CNTL_OFF); const int nMt = *(const LAS int*)(lds + NMT_OFF);
        for (int p = gw; p < nMt * 256; p += NGW) {
            const int e = texp[p >> 8], idx = p - pads[e];
            GAS v4u* dst = (GAS v4u*)(XG + (size_t)p * D) + lane;
            if (idx < cl[e]) { const int tok = tok_by_e[(size_t)e * T + idx]; const GAS v4u* src = (const GAS v4u*)(H2 + (size_t)tok * D) + lane;
#pragma unroll
                for (int j = 0; j < 4; ++j) dst[64 * j] = src[64 * j]; }
            else {
#pragma unroll
                for (int j = 0; j < 4; ++j) dst[64 * j] = (v4u){0u, 0u, 0u, 0u}; }
        }
    }
    SEAM(11);
    if (IN(12)) {
        moe_tiles(cnt_g, lds, tid);
        const LAS int* texp = (const LAS int*)(lds + TEXP_OFF); const int nMt = *(const LAS int*)(lds + NMT_OFF);
        pg8::Gemm g{XG, W1_T, nMt * 256, HID, D, D, D}; pg8::StaticOrder S; S.init(nMt * 256, HID, G, bx); S.texp = texp; S.estride = (size_t)HID * D * 2;
        pg8::EpiSwiglu E{ACT, args.in[26], texp};
        pg8::gemm_phase<pg8::EpiSwiglu, pg8::StaticOrder, true, true>(lds + RING_OFF, g, S, E);
    }
    SEAM(12);
    if (IN(13)) {
        moe_tiles(cnt_g, lds, tid);
        const LAS int* texp = (const LAS int*)(lds + TEXP_OFF); const int nMt = *(const LAS int*)(lds + NMT_OFF);
        pg8::Gemm g{ACT, W2_T, nMt * 256, D, FF, FF, FF}; pg8::StaticOrder S; S.init(nMt * 256, D, G, bx); S.texp = texp; S.estride = (size_t)D * FF * 2;
        pg8::EpiEo E{EO, args.in[28], texp};
        pg8::gemm_phase<pg8::EpiEo, pg8::StaticOrder, true, true>(lds + RING_OFF, g, S, E);
    }
    SEAM(13);
    if (IN(14)) {
        moe_tiles(cnt_g, lds, tid);
        const LAS int* pads = (const LAS int*)(lds + PADS_OFF);
        for (int t = gw; t < T; t += NGW) {
            int slot[4]; float gk[4];
#pragma unroll
            for (int k = 0; k < 4; ++k) { slot[k] = pads[route_e[t * 4 + k]] + route_rank[t * 4 + k]; gk[k] = route_gate[t * 4 + k]; }
            GAS f32x4* orow = (GAS f32x4*)(out + (size_t)t * D);
#pragma unroll
            for (int j = 0; j < 4; ++j) {
                const int c8 = lane + 64 * j;
                f32x4 a0 = orow[2 * c8], a1 = orow[2 * c8 + 1];
#pragma unroll
                for (int k = 0; k < 4; ++k) { const v4u w = *((const GAS v4u*)(EO + (size_t)slot[k] * D) + c8); const float g = gk[k];
                    a0.x += g * bf2f(w.x & 0xffffu); a0.y += g * bf2f(w.x >> 16); a0.z += g * bf2f(w.y & 0xffffu); a0.w += g * bf2f(w.y >> 16);
                    a1.x += g * bf2f(w.z & 0xffffu); a1.y += g * bf2f(w.z >> 16); a1.z += g * bf2f(w.w & 0xffffu); a1.w += g * bf2f(w.w >> 16); }
                orow[2 * c8] = a0; orow[2 * c8 + 1] = a1;
            }
        }
    }
#undef IN
#undef SEAM
}

extern "C" void kernel_launch(void* const* d_in, const int* in_sizes, int n_in, void* d_out, int out_size, void* d_ws, size_t ws_size, hipStream_t stream) {
    static int grid = 0;
    if (grid == 0) {
        if (n_in != 29 || out_size != T * D || ws_size < WS_END) { fprintf(stderr, "kernel_launch: unexpected shapes (n_in %d out %d ws %zu)\n", n_in, out_size, ws_size); grid = -1; return; }
        int dev = 0, cus = 0, per_cu = 0;
        if (hipGetDevice(&dev) != hipSuccess || hipDeviceGetAttribute(&cus, hipDeviceAttributeMultiprocessorCount, dev) != hipSuccess) { grid = -1; return; }
        if (hipFuncSetAttribute((const void*)fwd_kernel, hipFuncAttributeMaxDynamicSharedMemorySize, LDS_BYTES) != hipSuccess) { fprintf(stderr, "kernel_launch: hipFuncSetAttribute failed\n"); grid = -1; return; }
        if (hipOccupancyMaxActiveBlocksPerMultiprocessor(&per_cu, (const void*)fwd_kernel, NTHR, LDS_BYTES) != hipSuccess || per_cu < 1) fprintf(stderr, "kernel_launch: occupancy query reports %d\n", per_cu);
        (void)hipGetLastError();
        grid = cus;
    }
    if (grid < 0) return;
    (void)hipMemsetAsync((char*)d_ws + WS_CTL, 0, CTL_ZERO_BYTES, stream);
    Args a{};
    for (int i = 0; i < 29; ++i) a.in[i] = (const float*)d_in[i];
    a.out = (float*)d_out; a.ws = (unsigned char*)d_ws;
#ifndef N_LAUNCH_SPLIT
#define N_LAUNCH_SPLIT 1
#endif
#if N_LAUNCH_SPLIT
    for (int ph = 0; ph < NPHASE; ++ph) { a.ph_lo = ph; a.ph_hi = ph + 1; hipLaunchKernelGGL(fwd_kernel, dim3(grid), dim3(NTHR), LDS_BYTES, stream, a); }
#else
    a.ph_lo = 0; a.ph_hi = NPHASE; hipLaunchKernelGGL(fwd_kernel, dim3(grid), dim3(NTHR), LDS_BYTES, stream, a);
#endif
}
```

```cpp
#include <hip/hip_runtime.h>
#include <cstdio>
#include <cstdint>
#include <type_traits>
namespace pg8 {
#define PG8_LAS __attribute__((address_space(3)))
typedef unsigned short bf16_t;
typedef short bf16x8 __attribute__((ext_vector_type(8)));
typedef float f32x4 __attribute__((ext_vector_type(4)));
typedef unsigned u32x4 __attribute__((ext_vector_type(4)));
typedef int v4i_t __attribute__((ext_vector_type(4)));
constexpr int BM = 256, BK = 64, HALF = 128, HTB = HALF * BK * 2  , STAGE_BYTES = 8 * HTB, NXCD = 8, WGM = 8;

__host__ __device__ __forceinline__ int lds_byte(int r, int c) { const int st = (r >> 4) * 2 + (c >> 5), rr = r & 15, cc = c & 31, ob = rr * 64 + cc * 2; return st * 1024 + (ob ^ (((ob >> 9) & 1) << 5)); }
__host__ __device__ __forceinline__ void stage_rc(int b, int& R, int& C) { const int st = b / 1024, sb = b % 1024, swz = sb ^ (((sb >> 9) & 1) << 5); R = (st >> 1) * 16 + swz / 64; C = (st & 1) * 32 + (swz % 64) / 2; }
__host__ __device__ __forceinline__ int perm32(int rho) { const int n = rho >> 4, i = rho & 15; return 8 * (i >> 2) + 4 * n + (i & 3); }

struct Unit { int pm, pn, slot; };
struct Gemm { const bf16_t* A; const bf16_t* Bt; int M, N, K, lda, ldb; };

struct StaticOrder {
    static constexpr bool GATHER = false;
    int nM, nN, nwg, G, c; const PG8_LAS int* texp; size_t estride; const PG8_LAS int* arow;
    __host__ __device__ void init(int M, int N, int G_, int c_) { nM = M / BM; nN = N / BM; nwg = nM * nN; G = G_; c = c_; texp = nullptr; estride = 0; arow = nullptr; }
    __device__ __forceinline__ size_t aoff(const Unit& u, size_t tstepA) const { return arow ? (size_t)arow[u.pm] * (tstepA / BM) : (size_t)u.pm * tstepA; }
    __device__ __forceinline__ size_t boff(const Unit& u) const { return texp ? (size_t)texp[u.pm] * estride : (size_t)0; }
    __host__ __device__ bool next(int i, Unit& u) const {
        const long L = (long)i * G + c; if (L >= nwg) return false;
        int wgid = (int)L; { const int q = nwg / NXCD, r = nwg % NXCD, xcd = wgid % NXCD, off = wgid / NXCD; wgid = (xcd < r ? xcd * (q + 1) : r * (q + 1) + (xcd - r) * q) + off; }
        const int nig = WGM * nN, gid = wgid / nig, fm = gid * WGM, gsz = (nM - fm) < WGM ? (nM - fm) : WGM;
        u.pm = fm + ((wgid % nig) % gsz); u.pn = (wgid % nig) / gsz; u.slot = i % 3; return true;
    }
    __device__ __forceinline__ int tokrow(int, int) const { return 0; }
    __device__ __forceinline__ void gather_init(const Unit&) const {}
    __device__ __forceinline__ void a_ready(const Unit&) const {}
    __device__ __forceinline__ void done(const Unit&) const {}
};
struct PairOrder : StaticOrder {
    size_t a1, b1;
    __device__ __forceinline__ size_t aoff(const Unit& u, size_t tstepA) const { return (size_t)u.pm * tstepA + (u.slot ? a1 : (size_t)0); }
    __device__ __forceinline__ size_t boff(const Unit& u) const { return u.slot ? b1 : (size_t)0; }
    __host__ __device__ bool next(int i, Unit& u) const { if (!StaticOrder::next(i >> 1, u)) return false; u.slot = i & 1; return true; }
};
template <class E, class = void> struct epi_keep : std::false_type {};
template <class E> struct epi_keep<E, std::void_t<decltype(E::KEEP_ACC)>> : std::integral_constant<bool, E::KEEP_ACC> {};

typedef float f32x2_cv __attribute__((ext_vector_type(2))); typedef __bf16 bf16x2_cv __attribute__((ext_vector_type(2)));
__device__ __forceinline__ unsigned cvt_pk_bf16(float lo, float hi) { const f32x2_cv v = {lo, hi}; const bf16x2_cv b = __builtin_convertvector(v, bf16x2_cv); return __builtin_bit_cast(unsigned, b); }
typedef float f32x2 __attribute__((ext_vector_type(2)));
__device__ __forceinline__ f32x2 gelu_pk(f32x2 v) {
    const f32x2 av = __builtin_elementwise_abs(v), d = av * 0.2316418882f + 1.0f;
    f32x2 t; t.x = __builtin_amdgcn_rcpf(d.x); t.y = __builtin_amdgcn_rcpf(d.y);
    f32x2 q = t * 0.5307027145f + (-0.7265760135f); q = q * t + 0.7107068705f; q = q * t + (-0.142248368f); q = q * t + 0.127414796f; q = q * t;
    const f32x2 s = (v * v) * (-0.72134752044f);
    f32x2 e; e.x = __builtin_amdgcn_exp2f(s.x); e.y = __builtin_amdgcn_exp2f(s.y);
    const f32x2 m = v * (q * e), r = v - m;
    f32x2 o; o.x = v.x < 0.f ? m.x : r.x; o.y = v.y < 0.f ? m.y : r.y; return o;
}

template <int ACT  > struct EpiBf16 {
    static constexpr bool PERM = true, AFTER_DRAIN = false; static_assert(ACT == 0 || ACT == 1, "EpiBf16: ACT is 0 (none) or 1 (gelu_pk)");
    bf16_t* O; int ldc; const float* bias; int split_cols; size_t split_stride; float scale0;
    __device__ __forceinline__ void operator()(const f32x4 (&acc)[2][2][4][2], const Unit& u, int wr, int wc, int fr, int fq) const {
        const int row0 = u.pm * BM + wr * 64 + fr; int colt = u.pn * BM; bf16_t* base = O;
        float sc = 1.f; if (split_cols) { const int t = colt / split_cols; base += (size_t)t * split_stride; colt -= t * split_cols; if (t == 0) sc = scale0; }
        const int col0 = colt + wc * 32 + 8 * fq, bcol0 = u.pn * BM + wc * 32 + 8 * fq;
        f32x4 bv[2][2];
#pragma unroll
        for (int bj = 0; bj < 2; ++bj)
#pragma unroll
            for (int n = 0; n < 2; ++n) bv[bj][n] = bias ? *(const f32x4*)(bias + bcol0 + bj * HALF + 4 * n) : (f32x4){0.f, 0.f, 0.f, 0.f};
#pragma unroll
        for (int ai = 0; ai < 2; ++ai)
#pragma unroll
            for (int m = 0; m < 4; ++m) { bf16_t* rowp = base + (size_t)(row0 + ai * HALF + m * 16) * ldc + col0;
#pragma unroll
                for (int bj = 0; bj < 2; ++bj) { f32x4 v0 = acc[ai][bj][m][0] + bv[bj][0], v1 = acc[ai][bj][m][1] + bv[bj][1];
                    if (ACT == 1) { f32x2 a = gelu_pk((f32x2){v0[0], v0[1]}), b = gelu_pk((f32x2){v0[2], v0[3]}), c = gelu_pk((f32x2){v1[0], v1[1]}), d = gelu_pk((f32x2){v1[2], v1[3]});
                        v0 = (f32x4){a.x, a.y, b.x, b.y}; v1 = (f32x4){c.x, c.y, d.x, d.y}; }
                    v0 = v0 * sc; v1 = v1 * sc; u32x4 w; w.x = cvt_pk_bf16(v0[0], v0[1]); w.y = cvt_pk_bf16(v0[2], v0[3]); w.z = cvt_pk_bf16(v1[0], v1[1]); w.w = cvt_pk_bf16(v1[2], v1[3]);
                    *(u32x4*)(rowp + bj * HALF) = w; } }
    }
};

template <class Epi, class Sched, bool ALIGN_EPI = false, bool SP2 = false, int ES = 2  >
__device__ __forceinline__ void gemm_phase(PG8_LAS unsigned char* lds, const Gemm g, const Sched& S, const Epi& E) {
    const int tid = threadIdx.x, wid = __builtin_amdgcn_readfirstlane(tid >> 6), lane = tid & 63, wr = wid >> 2, wc = wid & 3, fr = lane & 15, fq = lane >> 4;
    const int K = g.K, nt = K * ES / (BK * 2);
    unsigned voffA[2], voffB[2];
#pragma unroll
    for (int i = 0; i < 2; ++i) { int R, C; stage_rc(tid * 16 + i * 8192, R, C); const int Rb = Epi::PERM ? ((R & ~31) + perm32(R & 31)) : R;
        voffA[i] = (unsigned)(R * g.lda * ES + C * 2); voffB[i] = (unsigned)(Rb * g.ldb * ES + C * 2); }
    const size_t kstep = (size_t)(BK * 2);
    constexpr bool GATHER = Sched::GATHER;
    static_assert(!GATHER || SP2, "the gathered-A path is written for the SP2 loop");
    const size_t hstepA = GATHER ? (size_t)0 : (size_t)HALF * g.lda * ES, hstepB = (size_t)HALF * g.ldb * ES;
    unsigned gc[2][2];
#pragma unroll
    for (int i = 0; i < 2; ++i) { gc[0][i] = gc[1][i] = 0u; }
#define PG8_GLOAD(dst, slot_) do { _Pragma("unroll") for (int i_ = 0; i_ < 2; ++i_) { int R_, C_; stage_rc(tid * 16 + i_ * 8192, R_, C_); _Pragma("unroll") for (int h_ = 0; h_ < 2; ++h_) \
        dst[h_][i_] = (unsigned)S.tokrow((slot_), h_ * HALF + R_) * (unsigned)(g.lda * ES) + (unsigned)(C_ * 2); } } while (0)
#define PG8_VAC(h, i) (GATHER ? gc[h][i] : voffA[i])
#define PG8_VAX(h, i) (GATHER ? gc[h][i] : voffA[i])
#define PG8_STAGE2(bufoff, gbase, v0, v1) do { \
        __builtin_amdgcn_global_load_lds((const unsigned*)((const char*)(gbase) + (v0)), (PG8_LAS unsigned*)(lds + (bufoff) + ldsw), 16, 0, 0); \
        __builtin_amdgcn_global_load_lds((const unsigned*)((const char*)(gbase) + (v1)), (PG8_LAS unsigned*)(lds + (bufoff) + ldsw + 8192), 16, 0, 0); } while (0)
    const size_t tstepA = 2 * hstepA, tstepB = 2 * hstepB;
    const unsigned ldsw = (unsigned)wid * 1024u;
    const int aoff = lds_byte(wr * 64 + fr, fq * 8), boff = lds_byte(wc * 32 + fr, fq * 8);
#define PG8_SA(b, h) (((b) * 2 + (h)) * HTB)
#define PG8_SB(b, h) ((4 + (b) * 2 + (h)) * HTB)
#define PG8_STAGE(bufoff, gbase, voff) do { _Pragma("unroll") for (int _i = 0; _i < 2; ++_i) \
        __builtin_amdgcn_global_load_lds((const unsigned*)((const char*)(gbase) + (voff)[_i]), (PG8_LAS unsigned*)(lds + (bufoff) + ldsw + _i * 8192), 16, 0, 0); } while (0)
#define PG8_RD(off) (*(const PG8_LAS v4i_t*)(lds + (off)))
#define PG8_LDA(dst, b, h) do { if constexpr (ES == 2) { _Pragma("unroll") for (int m = 0; m < 4; ++m) _Pragma("unroll") for (int k = 0; k < 2; ++k) dst[m][k] = __builtin_bit_cast(bf16x8, PG8_RD(PG8_SA(b, h) + aoff + m * 2048 + k * 1024)); } \
    else { _Pragma("unroll") for (int m = 0; m < 4; ++m) dst[m] = __builtin_shufflevector(PG8_RD(PG8_SA(b, h) + aoff + m * 2048), PG8_RD(PG8_SA(b, h) + aoff + m * 2048 + 1024), 0, 1, 2, 3, 4, 5, 6, 7); } } while (0)
#define PG8_LDB(dst, b, h) do { if constexpr (ES == 2) { _Pragma("unroll") for (int n = 0; n < 2; ++n) _Pragma("unroll") for (int k = 0; k < 2; ++k) dst[n][k] = __builtin_bit_cast(bf16x8, PG8_RD(PG8_SB(b, h) + boff + n * 2048 + k * 1024)); } \
    else { _Pragma("unroll") for (int n = 0; n < 2; ++n) dst[n] = __builtin_shufflevector(PG8_RD(PG8_SB(b, h) + boff + n * 2048), PG8_RD(PG8_SB(b, h) + boff + n * 2048 + 1024), 0, 1, 2, 3, 4, 5, 6, 7); } } while (0)
#define PG8_MMA(ai, bj, At, Bt) do { __builtin_amdgcn_s_setprio(1); if constexpr (ES == 2) { _Pragma("unroll") for (int m = 0; m < 4; ++m) _Pragma("unroll") for (int n = 0; n < 2; ++n) _Pragma("unroll") for (int k = 0; k < 2; ++k) \
        acc[ai][bj][m][n] = __builtin_amdgcn_mfma_f32_16x16x32_bf16(Bt[n][k], At[m][k], acc[ai][bj][m][n], 0, 0, 0); } else { _Pragma("unroll") for (int m = 0; m < 4; ++m) _Pragma("unroll") for (int n = 0; n < 2; ++n) \
        { if (m == 0 && n == 0) asm volatile("s_nop 4\n\tv_mfma_scale_f32_16x16x128_f8f6f4 %0, %1, %2, %0, %3, %3 op_sel_hi:[0,0,0]" : "+v"(acc[ai][bj][m][n]) : "v"(Bt[n]), "v"(At[m]), "v"(sc8)); \
        else asm volatile("v_mfma_scale_f32_16x16x128_f8f6f4 %0, %1, %2, %0, %3, %3 op_sel_hi:[0,0,0]" : "+v"(acc[ai][bj][m][n]) : "v"(Bt[n]), "v"(At[m]), "v"(sc8)); } } __builtin_amdgcn_s_setprio(0); } while (0)
#define PG8_WAIT_V(n) asm volatile("s_waitcnt vmcnt(" #n ")" ::: "memory")
#define PG8_WAIT_L(n) asm volatile("s_waitcnt lgkmcnt(" #n ")" ::: "memory")
#define PG8_BAR __builtin_amdgcn_s_barrier()
#define PG8_SCHED __builtin_amdgcn_sched_barrier(0)
    Unit cur, nxt; int ui = 0;
    if (!S.next(0, cur)) return;
    const int sc8 = 0x7f7f7f7f;
    f32x4 acc[2][2][4][2];
#pragma unroll
    for (int a = 0; a < 2; ++a)
#pragma unroll
        for (int b = 0; b < 2; ++b)
#pragma unroll
            for (int m = 0; m < 4; ++m)
#pragma unroll
                for (int n = 0; n < 2; ++n) acc[a][b][m][n] = (f32x4){0.f, 0.f, 0.f, 0.f};
    typedef int v8i_t __attribute__((ext_vector_type(8)));
    typename std::conditional<ES == 2, bf16x8[4][2], v8i_t[4]>::type At; typename std::conditional<ES == 2, bf16x8[2][2], v8i_t[2]>::type B0, B1;
    if constexpr (ES == 1) {
        asm volatile("s_nop 1" : "+v"(acc[0][0][0][0]), "+v"(acc[0][0][0][1]), "+v"(acc[0][0][1][0]), "+v"(acc[0][0][1][1]), "+v"(acc[0][0][2][0]), "+v"(acc[0][0][2][1]), "+v"(acc[0][0][3][0]), "+v"(acc[0][0][3][1]),
                                   "+v"(acc[0][1][0][0]), "+v"(acc[0][1][0][1]), "+v"(acc[0][1][1][0]), "+v"(acc[0][1][1][1]), "+v"(acc[0][1][2][0]), "+v"(acc[0][1][2][1]), "+v"(acc[0][1][3][0]), "+v"(acc[0][1][3][1]));
        asm volatile("s_nop 1" : "+v"(acc[1][0][0][0]), "+v"(acc[1][0][0][1]), "+v"(acc[1][0][1][0]), "+v"(acc[1][0][1][1]), "+v"(acc[1][0][2][0]), "+v"(acc[1][0][2][1]), "+v"(acc[1][0][3][0]), "+v"(acc[1][0][3][1]),
                                   "+v"(acc[1][1][0][0]), "+v"(acc[1][1][0][1]), "+v"(acc[1][1][1][0]), "+v"(acc[1][1][1][1]), "+v"(acc[1][1][2][0]), "+v"(acc[1][1][2][1]), "+v"(acc[1][1][3][0]), "+v"(acc[1][1][3][1]));
    }
    const char* cA = (const char*)g.A + (GATHER ? (size_t)0 : S.aoff(cur, tstepA)); const char* cB = (const char*)g.Bt + (size_t)cur.pn * tstepB + S.boff(cur);
    S.a_ready(cur);
    if constexpr (GATHER) { S.gather_init(cur); PG8_GLOAD(gc, cur.slot); }
    if constexpr (SP2) {
        PG8_STAGE(PG8_SB(0, 0), cB, voffB); PG8_STAGE(PG8_SB(0, 1), cB + hstepB, voffB); PG8_STAGE2(PG8_SA(0, 0), cA, PG8_VAC(0, 0), PG8_VAC(0, 1)); PG8_STAGE2(PG8_SA(0, 1), cA + hstepA, PG8_VAC(1, 0), PG8_VAC(1, 1));
        if (wr == 1) PG8_BAR;
        PG8_WAIT_V(2); PG8_BAR;
        PG8_STAGE(PG8_SB(1, 0), cB + kstep, voffB); PG8_STAGE2(PG8_SA(1, 0), cA + kstep, PG8_VAC(0, 0), PG8_VAC(0, 1)); PG8_STAGE(PG8_SB(1, 1), cB + hstepB + kstep, voffB);
        PG8_WAIT_V(6); PG8_BAR;
    } else {
        PG8_STAGE(PG8_SB(0, 0), cB, voffB); PG8_STAGE(PG8_SA(0, 0), cA, voffA); PG8_STAGE(PG8_SB(0, 1), cB + hstepB, voffB); PG8_STAGE(PG8_SA(0, 1), cA + hstepA, voffA);
        if (wr == 1) PG8_BAR;
        PG8_WAIT_V(4); PG8_BAR;
        PG8_STAGE(PG8_SB(1, 0), cB + kstep, voffB); PG8_STAGE(PG8_SA(1, 0), cA + kstep, voffA); PG8_STAGE(PG8_SB(1, 1), cB + hstepB + kstep, voffB);
        PG8_WAIT_V(6); PG8_BAR;
    }
    for (;;) {
        const bool has_next = S.next(ui + 1, nxt);
        const char* nA = (has_next && !GATHER) ? (const char*)g.A + S.aoff(nxt, tstepA) : cA; const char* nB = has_next ? (const char*)g.Bt + (size_t)nxt.pn * tstepB + S.boff(nxt) : cB;
        for (int t = 0; t < nt; t += 2) {
            const bool last = (t == nt - 2);
            const char* a1 = cA + (size_t)(t + 1) * kstep;
            const char* a2 = last ? nA : cA + (size_t)(t + 2) * kstep; const char* b2 = last ? nB : cB + (size_t)(t + 2) * kstep;
            const char* a3 = a2 + kstep; const char* b3 = b2 + kstep;
            if (last && has_next) S.a_ready(nxt);
            if constexpr (SP2) {
            PG8_LDB(B0, 0, 0); PG8_LDB(B1, 0, 1); PG8_SCHED; PG8_LDA(At, 0, 0); PG8_STAGE2(PG8_SA(1, 1), a1 + hstepA, PG8_VAC(1, 0), PG8_VAC(1, 1)); if constexpr (GATHER) { if (last && has_next) PG8_GLOAD(gc, nxt.slot); }
            PG8_WAIT_V(8); PG8_WAIT_L(0); PG8_BAR; PG8_MMA(0, 0, At, B0); PG8_MMA(0, 1, At, B1); PG8_BAR; PG8_SCHED;
            PG8_LDA(At, 0, 1); PG8_STAGE(PG8_SB(0, 0), b2, voffB); PG8_STAGE(PG8_SB(0, 1), b2 + hstepB, voffB); PG8_STAGE2(PG8_SA(0, 0), a2, PG8_VAX(0, 0), PG8_VAX(0, 1));
            PG8_WAIT_V(8); PG8_WAIT_L(0); PG8_BAR; PG8_MMA(1, 0, At, B0); PG8_MMA(1, 1, At, B1); PG8_BAR; PG8_SCHED;
            PG8_LDB(B0, 1, 0); PG8_LDB(B1, 1, 1); PG8_SCHED; PG8_LDA(At, 1, 0); PG8_STAGE2(PG8_SA(0, 1), a2 + hstepA, PG8_VAX(1, 0), PG8_VAX(1, 1));
            PG8_WAIT_V(8); PG8_WAIT_L(0); PG8_BAR; PG8_MMA(0, 0, At, B0); PG8_MMA(0, 1, At, B1); PG8_BAR; PG8_SCHED;
            PG8_LDA(At, 1, 1); PG8_STAGE(PG8_SB(1, 0), b3, voffB); PG8_STAGE(PG8_SB(1, 1), b3 + hstepB, voffB); PG8_STAGE2(PG8_SA(1, 0), a3, PG8_VAX(0, 0), PG8_VAX(0, 1));
            PG8_WAIT_V(8); PG8_WAIT_L(0); PG8_BAR; PG8_MMA(1, 0, At, B0); PG8_MMA(1, 1, At, B1); PG8_BAR; PG8_SCHED;
            } else {
            PG8_LDB(B0, 0, 0); PG8_SCHED; PG8_LDA(At, 0, 0); PG8_STAGE(PG8_SA(1, 1), a1 + hstepA, voffA);
            PG8_WAIT_L(8); PG8_BAR; PG8_WAIT_L(0); PG8_MMA(0, 0, At, B0); PG8_BAR; PG8_SCHED;
            PG8_LDB(B1, 0, 1); PG8_STAGE(PG8_SB(0, 0), b2, voffB);
            PG8_BAR; PG8_WAIT_L(0); PG8_MMA(0, 1, At, B1); PG8_BAR;
            PG8_LDA(At, 0, 1); PG8_STAGE(PG8_SA(0, 0), a2, voffA);
            PG8_BAR; PG8_WAIT_L(0); PG8_MMA(1, 0, At, B0); PG8_BAR; PG8_SCHED;
            PG8_STAGE(PG8_SB(0, 1), b2 + hstepB, voffB);
            PG8_WAIT_V(6); PG8_BAR; PG8_MMA(1, 1, At, B1); PG8_BAR;
            PG8_LDB(B0, 1, 0); PG8_SCHED; PG8_LDA(At, 1, 0); PG8_STAGE(PG8_SA(0, 1), a2 + hstepA, voffA);
            PG8_WAIT_L(8); PG8_BAR; PG8_WAIT_L(0); PG8_MMA(0, 0, At, B0); PG8_BAR; PG8_SCHED;
            PG8_LDB(B1, 1, 1); PG8_STAGE(PG8_SB(1, 0), b3, voffB);
            PG8_BAR; PG8_WAIT_L(0); PG8_MMA(0, 1, At, B1); PG8_BAR;
            PG8_LDA(At, 1, 1); PG8_STAGE(PG8_SA(1, 0), a3, voffA);
            PG8_BAR; PG8_WAIT_L(0); PG8_MMA(1, 0, At, B0); PG8_BAR; PG8_SCHED;
            PG8_STAGE(PG8_SB(1, 1), b3 + hstepB, voffB);
            PG8_WAIT_V(6); PG8_BAR; PG8_MMA(1, 1, At, B1); PG8_BAR;
            }
        }
        if constexpr (ALIGN_EPI) { if (wr == 0) PG8_BAR; }
        if constexpr (ES == 1) {
            asm volatile("s_nop 15\n\ts_nop 15" : "+v"(acc[1][0][0][0]), "+v"(acc[1][0][0][1]), "+v"(acc[1][0][1][0]), "+v"(acc[1][0][1][1]), "+v"(acc[1][0][2][0]), "+v"(acc[1][0][2][1]), "+v"(acc[1][0][3][0]), "+v"(acc[1][0][3][1]),
                                                       "+v"(acc[1][1][0][0]), "+v"(acc[1][1][0][1]), "+v"(acc[1][1][1][0]), "+v"(acc[1][1][1][1]), "+v"(acc[1][1][2][0]), "+v"(acc[1][1][2][1]), "+v"(acc[1][1][3][0]), "+v"(acc[1][1][3][1]));
            asm volatile("" : "+v"(acc[0][0][0][0]), "+v"(acc[0][0][0][1]), "+v"(acc[0][0][1][0]), "+v"(acc[0][0][1][1]), "+v"(acc[0][0][2][0]), "+v"(acc[0][0][2][1]), "+v"(acc[0][0][3][0]), "+v"(acc[0][0][3][1]),
                                "+v"(acc[0][1][0][0]), "+v"(acc[0][1][0][1]), "+v"(acc[0][1][1][0]), "+v"(acc[0][1][1][1]), "+v"(acc[0][1][2][0]), "+v"(acc[0][1][2][1]), "+v"(acc[0][1][3][0]), "+v"(acc[0][1][3][1]));
        }
        bool keep_acc = false;
        if constexpr (!Epi::AFTER_DRAIN) { if constexpr (epi_keep<Epi>::value) { if (cur.slot == 0) { E.mid(acc, cur, wr, wc, fr, fq); keep_acc = true; } else E(acc, cur, wr, wc, fr, fq); } else E(acc, cur, wr, wc, fr, fq); S.done(cur); }
        if (!has_next) break;
        if (!keep_acc) {
#pragma unroll
        for (int a = 0; a < 2; ++a)
#pragma unroll
            for (int b = 0; b < 2; ++b)
#pragma unroll
                for (int m = 0; m < 4; ++m)
#pragma unroll
                    for (int n = 0; n < 2; ++n) acc[a][b][m][n] = (f32x4){0.f, 0.f, 0.f, 0.f};
        }
        if constexpr (ES == 1) {
            asm volatile("s_nop 1" : "+v"(acc[0][0][0][0]), "+v"(acc[0][0][0][1]), "+v"(acc[0][0][1][0]), "+v"(acc[0][0][1][1]), "+v"(acc[0][0][2][0]), "+v"(acc[0][0][2][1]), "+v"(acc[0][0][3][0]), "+v"(acc[0][0][3][1]),
                                       "+v"(acc[0][1][0][0]), "+v"(acc[0][1][0][1]), "+v"(acc[0][1][1][0]), "+v"(acc[0][1][1][1]), "+v"(acc[0][1][2][0]), "+v"(acc[0][1][2][1]), "+v"(acc[0][1][3][0]), "+v"(acc[0][1][3][1]));
            asm volatile("s_nop 1" : "+v"(acc[1][0][0][0]), "+v"(acc[1][0][0][1]), "+v"(acc[1][0][1][0]), "+v"(acc[1][0][1][1]), "+v"(acc[1][0][2][0]), "+v"(acc[1][0][2][1]), "+v"(acc[1][0][3][0]), "+v"(acc[1][0][3][1]),
                                       "+v"(acc[1][1][0][0]), "+v"(acc[1][1][0][1]), "+v"(acc[1][1][1][0]), "+v"(acc[1][1][1][1]), "+v"(acc[1][1][2][0]), "+v"(acc[1][1][2][1]), "+v"(acc[1][1][3][0]), "+v"(acc[1][1][3][1]));
        }
        cur = nxt; cA = nA; cB = nB; ++ui;

        if constexpr (ALIGN_EPI) { if (wr == 1) PG8_BAR; }
    }
    PG8_WAIT_V(0);
    if constexpr (!ALIGN_EPI) { if (wr == 0) PG8_BAR; }
    PG8_BAR;
    if constexpr (Epi::AFTER_DRAIN) { E.fused(acc, cur, wr, wc, fr, fq, lds, wid, lane); S.done(cur); }
#undef PG8_SA
#undef PG8_SB
#undef PG8_STAGE
#undef PG8_STAGE2
#undef PG8_GLOAD
#undef PG8_VAC
#undef PG8_VAX
#undef PG8_LDA
#undef PG8_LDB
#undef PG8_MMA
#undef PG8_RD
#undef PG8_WAIT_V
#undef PG8_WAIT_L
#undef PG8_BAR
#undef PG8_SCHED
}
}

#define GAS __attribute__((address_space(1)))
#define LAS __attribute__((address_space(3)))
#define DEV __device__ __forceinline__
typedef unsigned short bf16;
typedef unsigned v4u __attribute__((ext_vector_type(4)));
typedef unsigned v2u __attribute__((ext_vector_type(2)));
typedef float f32x4 __attribute__((ext_vector_type(4)));
typedef GAS unsigned gu32;
#define RLX_AGENT __ATOMIC_RELAXED, __HIP_MEMORY_SCOPE_AGENT
#define LDS_WAIT() asm volatile("s_waitcnt lgkmcnt(0)" ::: "memory")
#define VM_WAIT() asm volatile("s_waitcnt vmcnt(0)" ::: "memory")

constexpr int NB = 4, SEQ = 4096, T = NB * SEQ, D = 2048;
constexpr int NH = 8, DK = 64, DV = 128, AW = 1024, LW = 1024;
constexpr int P5P = 5120;
constexpr int INC = 9216;
constexpr int C_Q = 0, C_K = 1024, C_V = 2048, C_XL = 3072, C_GL = 4096, C_GT = 5120;
constexpr int NE = 32, TOPK = 4, HID = 4096, FF = 2048;
constexpr int MAXTILES = 288, PMAX = MAXTILES * 256;
constexpr float RMS_EPS = 1e-6f;
constexpr int NWAVES = 8, NTHR = 512;

constexpr size_t MiB = (size_t)1 << 20;
constexpr size_t WS_CTL = 0, CTL_ZERO_BYTES = 1 * MiB;
constexpr size_t WS_WIN = 2 * MiB, WS_WA = 38 * MiB, WS_WB = 42 * MiB, WS_WOUT = 46 * MiB;
constexpr size_t WS_ROUTE = 54 * MiB;
constexpr size_t WS_WL = 57 * MiB;
constexpr size_t WS_W1 = 64 * MiB, WS_W2 = 576 * MiB;
constexpr size_t WS_H = 832 * MiB, WS_PROJ = 896 * MiB, WS_Q = 1184 * MiB, WS_K = 1216 * MiB, WS_OAB = 1248 * MiB;
constexpr size_t WS_LA = 1312 * MiB, WS_LU = 1376 * MiB, WS_YA = 1440 * MiB, WS_YB = 1504 * MiB, WS_MIX = 1568 * MiB, WS_H2 = 1632 * MiB;
constexpr size_t WS_XG = 1696 * MiB, WS_ACT = 1984 * MiB, WS_EO = 2272 * MiB;
constexpr size_t WS_XGS = 2560 * MiB  , WS_RSS = 3584 * MiB  , WS_END = 3588 * MiB;
constexpr int CW_TMO = 0, CW_CODE = 1, CW_CNT = 8192  , CW_BAR = 4096;

constexpr int RING_OFF = 0, RING_BYTES = 131072;
constexpr int LDSCTL_OFF = RING_BYTES;
constexpr int MISC_OFF = LDSCTL_OFF;
constexpr int TEXP_OFF = LDSCTL_OFF + 256;
constexpr int PADS_OFF = TEXP_OFF + 1280;
constexpr int CNTL_OFF = PADS_OFF + 256;
constexpr int NMT_OFF = CNTL_OFF + 256;
constexpr int AROW_OFF = NMT_OFF + 64;
constexpr int TOKT_OFF = AROW_OFF + 1280;
constexpr int LDS_BYTES = 147456;
static_assert(TOKT_OFF + 3072 <= LDS_BYTES, "LDS map");

DEV float bf2f(unsigned v) { return __uint_as_float(v << 16); }
DEV unsigned f2bf(float f) { unsigned u = __builtin_bit_cast(unsigned, f); return (u + 0x7fffu + ((u >> 16) & 1u)) >> 16; }
DEV unsigned pk2(float lo, float hi) { return f2bf(lo) | (f2bf(hi) << 16); }
DEV float wave_sum(float v) {
#pragma unroll
    for (int o = 1; o < 64; o <<= 1) v += __shfl_xor(v, o);
    return v;
}
DEV float wave_max(float v) {
#pragma unroll
    for (int o = 1; o < 64; o <<= 1) v = fmaxf(v, __shfl_xor(v, o));
    return v;
}
DEV float sigmoidf_(float x) { return __builtin_amdgcn_rcpf(1.0f + __expf(-x)); }
DEV float gelu_tanh(float x) { const float u = 0.7978845608028654f * (x + 0.044715f * x * x * x); return 0.5f * x * (1.0f + tanhf(u)); }

DEV int t5_bucket(int rel) {
    const int ret = rel > 0 ? 16 : 0; const int n = rel < 0 ? -rel : rel;
    int v;
    if (n < 8) v = n;
    else if (n >= 128) v = 15;
    else { const int l2 = 31 - __builtin_clz((unsigned)(n * n)); int lg = 8 + (l2 - 6); v = lg < 15 ? lg : 15; }
    return ret + v;
}

#define XB_TMO      128
#define XB_XCNT(j)  (256  + 64 * (j))
#define XB_XSUB(j)  (1280 + 64 * (j))
#define XB_XGEN(j)  (2304 + 64 * (j))
#define XB_TOP      3328
#define XB_TOPGEN   3392
#define XCD_BAR_WORDS 3456
#define XB_SPIN_CAP (1u << 18)
DEV unsigned xb_ld(unsigned* p)              { return __hip_atomic_load(p, __ATOMIC_RELAXED, __HIP_MEMORY_SCOPE_AGENT); }
DEV unsigned xb_add(unsigned* p, unsigned v) { return __hip_atomic_fetch_add(p, v, __ATOMIC_RELAXED, __HIP_MEMORY_SCOPE_AGENT); }
DEV unsigned xb_xcc_id() { return (unsigned)__builtin_amdgcn_s_getreg((3 << 11) | 20) & 0xFu; }
#define XB_SPIN(cond, bar) do { unsigned _sp = 0; while (cond) { __builtin_amdgcn_s_sleep(1); \
    if ((++_sp & 255u) == 0u) { if (xb_ld(&(bar)[XB_TMO])) break; if (_sp > XB_SPIN_CAP) { atomicAdd(&(bar)[XB_TMO], 1u); break; } } } } while (0)
struct XcdBarrier { unsigned* bar; unsigned x; volatile LAS unsigned* st; };
DEV XcdBarrier xcd_barrier_post(unsigned* bar, volatile LAS unsigned* st) {
    XcdBarrier b; b.bar = bar; b.x = xb_xcc_id(); b.st = st;
    if (threadIdx.x == 0) (void)xb_add(&bar[XB_XCNT(b.x)], 1u);
    return b;
}
DEV void xcd_barrier_complete(unsigned* bar, unsigned x, unsigned& nloc, unsigned& nx) {
    const unsigned G = gridDim.x * gridDim.y * gridDim.z;
    unsigned sum, cnt, mine, sp = 0u;
    for (;;) {
        sum = 0u; cnt = 0u; mine = 0u;
#pragma unroll
        for (unsigned j = 0; j < 16; ++j) { const unsigned c = xb_ld(&bar[XB_XCNT(j)]); sum += c; cnt += (c > 0u) ? 1u : 0u; mine = (j == x) ? c : mine; }
        if (sum == G) break;
        __builtin_amdgcn_s_sleep(1);
        if ((++sp & 255u) == 0u) { if (xb_ld(&bar[XB_TMO])) break; if (sp > XB_SPIN_CAP) { atomicAdd(&bar[XB_TMO], 1u); break; } }
    }
    nloc = mine > 0u ? mine : 1u; nx = cnt > 0u ? cnt : 1u;
}
DEV void xcd_barrier(const XcdBarrier& b) {
    asm volatile("s_waitcnt vmcnt(0)" ::: "memory");
    __syncthreads();
    if (threadIdx.x == 0) {
        unsigned* bar = b.bar;
        __builtin_amdgcn_s_waitcnt(0);
        unsigned nloc = b.st[0], nx = b.st[1];
        if (nloc == 0u) { xcd_barrier_complete(bar, b.x, nloc, nx); b.st[0] = nloc; b.st[1] = nx; }
        const unsigned old = xb_add(&bar[XB_XSUB(b.x)], 1u);
        const unsigned gen = old / nloc;
        if (old + 1u == (gen + 1u) * nloc) {
            __builtin_amdgcn_fence(__ATOMIC_RELEASE, "agent");
            asm volatile("s_waitcnt vmcnt(0)" ::: "memory");
            const unsigned og = xb_add(&bar[XB_TOP], 1u);
            const unsigned tg = og / nx;
            if (og + 1u == (tg + 1u) * nx) xb_add(&bar[XB_TOPGEN], 1u);
            else XB_SPIN(xb_ld(&bar[XB_TOPGEN]) == tg, bar);
            __builtin_amdgcn_fence(__ATOMIC_ACQUIRE, "agent");
            xb_add(&bar[XB_XGEN(b.x)], 1u);
            asm volatile("s_waitcnt vmcnt(0)" ::: "memory");
        } else {
            XB_SPIN(xb_ld(&bar[XB_XGEN(b.x)]) == gen, bar);
            __builtin_amdgcn_fence(__ATOMIC_ACQUIRE, "agent");
            asm volatile("s_waitcnt vmcnt(0)" ::: "memory");
        }
    }
    __syncthreads();
}

namespace pg8 {

struct EpiProj {
    static constexpr bool PERM = true, AFTER_DRAIN = false;
    bf16_t* P5; bf16_t* G; const float* qg; const float* kg; const float* bgate; int pn_off; float asc;
    static __device__ __forceinline__ float gelu_t(float x) { const float u = 1.5957691216057308f * (x + 0.044715f * x * x * x); return x * __builtin_amdgcn_rcpf(1.0f + __expf(-u)); }
    static __device__ __forceinline__ float sigm(float x) { return __builtin_amdgcn_rcpf(1.0f + __expf(-x)); }
    static __device__ __forceinline__ unsigned q8(float z) { return (unsigned)fmaxf(sigm(z) * 255.0f + 0.5f, 1.0f); }
    __device__ __forceinline__ void operator()(const f32x4 (&acc_)[2][2][4][2], const Unit& u, int wr, int wc, int fr, int fq) const {
        const int pn = u.pn + pn_off, row0 = u.pm * BM + wr * 64 + fr;
        f32x4 acc[2][2][4][2];
#pragma unroll
        for (int a = 0; a < 2; ++a)
#pragma unroll
            for (int b = 0; b < 2; ++b)
#pragma unroll
                for (int m = 0; m < 4; ++m)
#pragma unroll
                    for (int n = 0; n < 2; ++n) acc[a][b][m][n] = acc_[a][b][m][n] * asc;
        if (pn < 8) {
            const bool isk = pn >= 4; const float* gain = isk ? kg : qg; const float sc = isk ? 1.0f : 0.125f * 1.4426950408889634f;
            f32x4 gv[2][2];
#pragma unroll
            for (int bj = 0; bj < 2; ++bj)
#pragma unroll
                for (int n = 0; n < 2; ++n) gv[bj][n] = *(const f32x4*)(gain + 32 * bj + 8 * fq + 4 * n) * sc;
#pragma unroll
            for (int ai = 0; ai < 2; ++ai)
#pragma unroll
                for (int m = 0; m < 4; ++m) {
                    float ss = 0.f;
#pragma unroll
                    for (int bj = 0; bj < 2; ++bj)
#pragma unroll
                        for (int n = 0; n < 2; ++n) { const f32x4 v = acc[ai][bj][m][n]; ss += (v[0] * v[0] + v[1] * v[1]) + (v[2] * v[2] + v[3] * v[3]); }
                    ss += __shfl_xor(ss, 16); ss += __shfl_xor(ss, 32);
                    const float rstd = 1.0f / sqrtf(ss * (1.0f / 64.0f) + 1e-6f);
                    bf16_t* rowp = P5 + (size_t)(row0 + ai * HALF + m * 16) * 5120 + pn * BM + 64 * wc + 8 * fq;
#pragma unroll
                    for (int bj = 0; bj < 2; ++bj) { const f32x4 v0 = acc[ai][bj][m][0] * rstd * gv[bj][0], v1 = acc[ai][bj][m][1] * rstd * gv[bj][1];
                        u32x4 w; w.x = cvt_pk_bf16(v0[0], v0[1]); w.y = cvt_pk_bf16(v0[2], v0[3]); w.z = cvt_pk_bf16(v1[0], v1[1]); w.w = cvt_pk_bf16(v1[2], v1[3]);
                        *(u32x4*)(rowp + 32 * bj) = w; }
                }
        } else if (pn < 20) {
            const bool gl = pn >= 16; const int col0 = pn * BM + wc * 32 + 8 * fq;
#pragma unroll
            for (int ai = 0; ai < 2; ++ai)
#pragma unroll
                for (int m = 0; m < 4; ++m) { bf16_t* rowp = P5 + (size_t)(row0 + ai * HALF + m * 16) * 5120 + col0;
#pragma unroll
                    for (int bj = 0; bj < 2; ++bj) { f32x4 v0 = acc[ai][bj][m][0], v1 = acc[ai][bj][m][1];
                        if (gl) { v0 = (f32x4){gelu_t(v0[0]), gelu_t(v0[1]), gelu_t(v0[2]), gelu_t(v0[3])}; v1 = (f32x4){gelu_t(v1[0]), gelu_t(v1[1]), gelu_t(v1[2]), gelu_t(v1[3])}; }
                        u32x4 w; w.x = cvt_pk_bf16(v0[0], v0[1]); w.y = cvt_pk_bf16(v0[2], v0[3]); w.z = cvt_pk_bf16(v1[0], v1[1]); w.w = cvt_pk_bf16(v1[2], v1[3]);
                        *(u32x4*)(rowp + bj * HALF) = w; } }
        } else {
            const int col0 = (pn - 20) * BM + wc * 32 + 8 * fq;
            f32x4 bv[2][2];
#pragma unroll
            for (int bj = 0; bj < 2; ++bj)
#pragma unroll
                for (int n = 0; n < 2; ++n) bv[bj][n] = *(const f32x4*)(bgate + col0 + bj * HALF + 4 * n);
#pragma unroll
            for (int ai = 0; ai < 2; ++ai)
#pragma unroll
                for (int m = 0; m < 4; ++m) { unsigned char* rowp = (unsigned char*)G + (size_t)(row0 + ai * HALF + m * 16) * 4096 + col0;
#pragma unroll
                    for (int bj = 0; bj < 2; ++bj) { const f32x4 v0 = acc[ai][bj][m][0] + bv[bj][0], v1 = acc[ai][bj][m][1] + bv[bj][1];
                        typedef unsigned u32x2 __attribute__((ext_vector_type(2))); u32x2 w;
                        w.x = q8(v0[0]) | (q8(v0[1]) << 8) | (q8(v0[2]) << 16) | (q8(v0[3]) << 24); w.y = q8(v1[0]) | (q8(v1[1]) << 8) | (q8(v1[2]) << 16) | (q8(v1[3]) << 24);
                        *(u32x2*)(rowp + bj * HALF) = w; } }
        }
    }
};
template <int MODE> struct EpiMix {
    static constexpr bool PERM = true, AFTER_DRAIN = false;
    bf16_t* O; const bf16_t* G; const bf16_t* prev; int goff;
    static __device__ __forceinline__ float lo(unsigned w) { return __uint_as_float(w << 16); }
    static __device__ __forceinline__ float hi(unsigned w) { return __uint_as_float(w & 0xffff0000u); }
    __device__ __forceinline__ void operator()(const f32x4 (&acc)[2][2][4][2], const Unit& u, int wr, int wc, int fr, int fq) const {
        const int row0 = u.pm * BM + wr * 64 + fr, col0 = u.pn * BM + wc * 32 + 8 * fq;
#pragma unroll
        for (int ai = 0; ai < 2; ++ai)
#pragma unroll
            for (int m = 0; m < 4; ++m) { const size_t row = (size_t)(row0 + ai * HALF + m * 16);
#pragma unroll
                for (int bj = 0; bj < 2; ++bj) { typedef unsigned u32x2 __attribute__((ext_vector_type(2))); const u32x2 gw = *(const u32x2*)((const unsigned char*)G + row * 4096 + goff + col0 + bj * HALF);
                    f32x4 v0 = acc[ai][bj][m][0] * (1.0f / 255.0f), v1 = acc[ai][bj][m][1] * (1.0f / 255.0f);
                    v0 = (f32x4){v0[0] * (float)(gw.x & 0xffu), v0[1] * (float)((gw.x >> 8) & 0xffu), v0[2] * (float)((gw.x >> 16) & 0xffu), v0[3] * (float)(gw.x >> 24)}; v1 = (f32x4){v1[0] * (float)(gw.y & 0xffu), v1[1] * (float)((gw.y >> 8) & 0xffu), v1[2] * (float)((gw.y >> 16) & 0xffu), v1[3] * (float)(gw.y >> 24)};
                    if (MODE == 1) { const u32x4 pw = *(const u32x4*)(prev + row * 2048 + col0 + bj * HALF);
                        v0 = v0 + (f32x4){lo(pw.x), hi(pw.x), lo(pw.y), hi(pw.y)}; v1 = v1 + (f32x4){lo(pw.z), hi(pw.z), lo(pw.w), hi(pw.w)}; }
                    u32x4 w; w.x = cvt_pk_bf16(v0[0], v0[1]); w.y = cvt_pk_bf16(v0[2], v0[3]); w.z = cvt_pk_bf16(v1[0], v1[1]); w.w = cvt_pk_bf16(v1[2], v1[3]);
                    *(u32x4*)(O + row * 2048 + col0 + bj * HALF) = w; } }
    }
};
struct EpiMix2 {
    static constexpr bool PERM = true, AFTER_DRAIN = false, KEEP_ACC = true;
    bf16_t* O; const unsigned char* G8;
    typedef unsigned u32x2 __attribute__((ext_vector_type(2)));
    static __device__ __forceinline__ float ub(unsigned w, int i) { return (float)((w >> (8 * i)) & 0xffu); }
    __device__ __forceinline__ void mid(f32x4 (&acc)[2][2][4][2], const Unit& u, int wr, int wc, int fr, int fq) const {
        const int row0 = u.pm * BM + wr * 64 + fr, col0 = u.pn * BM + wc * 32 + 8 * fq;
#pragma unroll
        for (int ai = 0; ai < 2; ++ai)
#pragma unroll
            for (int m = 0; m < 4; ++m) { const unsigned char* gp = G8 + (size_t)(row0 + ai * HALF + m * 16) * 4096 + col0;
#pragma unroll
                for (int bj = 0; bj < 2; ++bj) { const u32x2 g0 = *(const u32x2*)(gp + bj * HALF), g1 = *(const u32x2*)(gp + 2048 + bj * HALF);
#pragma unroll
                    for (int j = 0; j < 4; ++j) { acc[ai][bj][m][0][j] *= ub(g0.x, j) * __builtin_amdgcn_rcpf(ub(g1.x, j)); acc[ai][bj][m][1][j] *= ub(g0.y, j) * __builtin_amdgcn_rcpf(ub(g1.y, j)); } } }
    }
    __device__ __forceinline__ void operator()(const f32x4 (&acc)[2][2][4][2], const Unit& u, int wr, int wc, int fr, int fq) const {
        const int row0 = u.pm * BM + wr * 64 + fr, col0 = u.pn * BM + wc * 32 + 8 * fq;
#pragma unroll
        for (int ai = 0; ai < 2; ++ai)
#pragma unroll
            for (int m = 0; m < 4; ++m) { const size_t row = (size_t)(row0 + ai * HALF + m * 16);
#pragma unroll
                for (int bj = 0; bj < 2; ++bj) { const u32x2 g1 = *(const u32x2*)(G8 + row * 4096 + 2048 + col0 + bj * HALF);
                    f32x4 v0 = acc[ai][bj][m][0] * (1.0f / 255.0f), v1 = acc[ai][bj][m][1] * (1.0f / 255.0f);
                    v0 = (f32x4){v0[0] * ub(g1.x, 0), v0[1] * ub(g1.x, 1), v0[2] * ub(g1.x, 2), v0[3] * ub(g1.x, 3)}; v1 = (f32x4){v1[0] * ub(g1.y, 0), v1[1] * ub(g1.y, 1), v1[2] * ub(g1.y, 2), v1[3] * ub(g1.y, 3)};
                    u32x4 w; w.x = cvt_pk_bf16(v0[0], v0[1]); w.y = cvt_pk_bf16(v0[2], v0[3]); w.z = cvt_pk_bf16(v1[0], v1[1]); w.w = cvt_pk_bf16(v1[2], v1[3]);
                    *(u32x4*)(O + row * 2048 + col0 + bj * HALF) = w; } }
    }
};
struct EpiF32Res {
    static constexpr bool PERM = false, AFTER_DRAIN = false;
    float* C; int ldc; const float* res;
    __device__ __forceinline__ void operator()(const f32x4 (&acc)[2][2][4][2], const Unit& u, int wr, int wc, int fr, int fq) const {
        const int row0 = u.pm * BM + wr * 64 + fr, col0 = u.pn * BM + wc * 32 + 4 * fq;
#pragma unroll
        for (int ai = 0; ai < 2; ++ai)
#pragma unroll
            for (int m = 0; m < 4; ++m) { const size_t off = (size_t)(row0 + ai * HALF + m * 16) * ldc + col0;
#pragma unroll
                for (int bj = 0; bj < 2; ++bj)
#pragma unroll
                    for (int n = 0; n < 2; ++n) { const f32x4 r = *(const f32x4*)(res + off + bj * HALF + n * 16); *(f32x4*)(C + off + bj * HALF + n * 16) = acc[ai][bj][m][n] + r; } }
    }
};
struct EpiBf16Res {
    static constexpr bool PERM = true, AFTER_DRAIN = false;
    bf16_t* O; const float* res;
    __device__ __forceinline__ void operator()(const f32x4 (&acc)[2][2][4][2], const Unit& u, int wr, int wc, int fr, int fq) const {
        const int row0 = u.pm * BM + wr * 64 + fr, col0 = u.pn * BM + wc * 32 + 8 * fq;
#pragma unroll
        for (int ai = 0; ai < 2; ++ai)
#pragma unroll
            for (int m = 0; m < 4; ++m) { const size_t off = (size_t)(row0 + ai * HALF + m * 16) * 2048 + col0;
#pragma unroll
                for (int bj = 0; bj < 2; ++bj) { const f32x4 r0 = *(const f32x4*)(res + off + bj * HALF), r1 = *(const f32x4*)(res + off + bj * HALF + 4);
                    const f32x4 v0 = acc[ai][bj][m][0] + r0, v1 = acc[ai][bj][m][1] + r1;
                    u32x4 w; w.x = cvt_pk_bf16(v0[0], v0[1]); w.y = cvt_pk_bf16(v0[2], v0[3]); w.z = cvt_pk_bf16(v1[0], v1[1]); w.w = cvt_pk_bf16(v1[2], v1[3]);
                    *(u32x4*)(O + off + bj * HALF) = w; } }
    }
};
struct EpiSwiglu {
    static constexpr bool PERM = true, AFTER_DRAIN = false;
    unsigned char* O; const float* b1; const PG8_LAS int* texp; const float* rstd; const PG8_LAS int* tokt;
    static __device__ __forceinline__ float sw(float g, float l) { g = fminf(g, 7.0f); l = fminf(fmaxf(l, -7.0f), 7.0f); return fminf(fmaxf(8.0f * g * __builtin_amdgcn_rcpf(1.0f + __expf(-1.702f * g)) * (l + 1.0f), -448.0f), 448.0f); }
    __device__ __forceinline__ void operator()(const f32x4 (&acc)[2][2][4][2], const Unit& u, int wr, int wc, int fr, int fq) const {
        const int e = texp[u.pm]; const float* bias = b1 + (size_t)e * 4096;
        const int row0 = u.pm * BM + wr * 64 + fr, col0 = u.pn * BM + wc * 32 + 8 * fq;
        f32x4 bv[2][2];
#pragma unroll
        for (int bj = 0; bj < 2; ++bj)
#pragma unroll
            for (int n = 0; n < 2; ++n) bv[bj][n] = *(const f32x4*)(bias + col0 + bj * HALF + 4 * n);
#pragma unroll
        for (int ai = 0; ai < 2; ++ai)
#pragma unroll
            for (int m = 0; m < 4; ++m) { unsigned char* rowp = O + (size_t)(row0 + ai * HALF + m * 16) * 2048 + (col0 >> 1); const float rsc = rstd[tokt[u.slot * 256 + wr * 64 + fr + ai * HALF + m * 16]] * (1.0f / 8192.0f);
#pragma unroll
                for (int bj = 0; bj < 2; ++bj) { const f32x4 v0 = acc[ai][bj][m][0] * rsc + bv[bj][0], v1 = acc[ai][bj][m][1] * rsc + bv[bj][1];
                    int w = __builtin_amdgcn_cvt_pk_fp8_f32(sw(v0[0], v0[1]), sw(v0[2], v0[3]), 0, false); w = __builtin_amdgcn_cvt_pk_fp8_f32(sw(v1[0], v1[1]), sw(v1[2], v1[3]), w, true);
                    *(int*)(rowp + bj * 64) = w; } }
    }
};
struct EpiEo {
    static constexpr bool PERM = true, AFTER_DRAIN = false;
    unsigned char* O; const float* b2; const PG8_LAS int* texp;
    static __device__ __forceinline__ float s8(float v) { return fminf(fmaxf(32.0f * v, -448.0f), 448.0f); }
    __device__ __forceinline__ void operator()(const f32x4 (&acc)[2][2][4][2], const Unit& u, int wr, int wc, int fr, int fq) const {
        const int e = texp[u.pm]; const float* bias = b2 + (size_t)e * 2048;
        const int row0 = u.pm * BM + wr * 64 + fr, col0 = u.pn * BM + wc * 32 + 8 * fq;
        f32x4 bv[2][2];
#pragma unroll
        for (int bj = 0; bj < 2; ++bj)
#pragma unroll
            for (int n = 0; n < 2; ++n) bv[bj][n] = *(const f32x4*)(bias + col0 + bj * HALF + 4 * n);
#pragma unroll
        for (int ai = 0; ai < 2; ++ai)
#pragma unroll
            for (int m = 0; m < 4; ++m) { int qa[2], qb[2];
#pragma unroll
                for (int bj = 0; bj < 2; ++bj) { const f32x4 v0 = acc[ai][bj][m][0] * (1.0f / 4096.0f) + bv[bj][0], v1 = acc[ai][bj][m][1] * (1.0f / 4096.0f) + bv[bj][1];
                    int a = __builtin_amdgcn_cvt_pk_fp8_f32(s8(v0[0]), s8(v0[1]), 0, false); a = __builtin_amdgcn_cvt_pk_fp8_f32(s8(v0[2]), s8(v0[3]), a, true);
                    int b = __builtin_amdgcn_cvt_pk_fp8_f32(s8(v1[0]), s8(v1[1]), 0, false); b = __builtin_amdgcn_cvt_pk_fp8_f32(s8(v1[2]), s8(v1[3]), b, true); qa[bj] = a; qb[bj] = b; }
                auto sa = __builtin_amdgcn_permlane16_swap((unsigned)qa[0], (unsigned)qa[1], false, false); auto sb = __builtin_amdgcn_permlane16_swap((unsigned)qb[0], (unsigned)qb[1], false, false);
                *(u32x4*)(O + (size_t)(row0 + ai * HALF + m * 16) * 2048 + u.pn * BM + wc * 32 + 8 * (fq & ~1) + HALF * (fq & 1)) = (u32x4){sa[0], sb[0], sa[1], sb[1]}; }
    }
};
}

DEV void p0_transpose_item(const float* W, int K, int N, bf16* WT, LAS float* scr, int item, int lane, bool qkperm = false, int NC = 0) {
    const int nblk = (NC ? NC : N) / 32, kb = item / nblk, nb = item % nblk, k0 = 64 * kb, n0 = 32 * nb;
    const int d0 = (qkperm && n0 < 2048) ? (n0 & ~255) + 128 * ((n0 >> 5) & 1) + 32 * ((n0 >> 6) & 3) : n0;
#pragma unroll 8
    for (int i = 0; i < 32; ++i) { const int kk = 2 * i + (lane >> 5); scr[kk * 33 + (lane & 31)] = W[(size_t)(k0 + kk) * N + n0 + (lane & 31)]; }
    LDS_WAIT(); asm volatile("" ::: "memory");
    const int c = lane & 7;
#pragma unroll
    for (int j = 0; j < 4; ++j) { const int n = (lane >> 3) + 8 * j; const LAS float* s = scr + (8 * c) * 33 + n;
        v4u o; o.x = pk2(s[0 * 33], s[1 * 33]); o.y = pk2(s[2 * 33], s[3 * 33]); o.z = pk2(s[4 * 33], s[5 * 33]); o.w = pk2(s[6 * 33], s[7 * 33]);
        *(GAS v4u*)(WT + (size_t)(d0 + n) * K + k0 + 8 * c) = o; }
    LDS_WAIT(); asm volatile("" ::: "memory");
}
DEV int pk4_fp8(float a, float b, float c, float d) { int w = __builtin_amdgcn_cvt_pk_fp8_f32(a, b, 0, false); return __builtin_amdgcn_cvt_pk_fp8_f32(c, d, w, true); }
DEV float sat8(float v) { return fminf(fmaxf(v, -448.0f), 448.0f); }
DEV void p0_transpose_item8(const float* W, int K, int N, unsigned char* WT8, LAS float* scr, int item, int lane, float scale) {
    const int nblk = N / 32, kb = item / nblk, nb = item % nblk, k0 = 64 * kb, n0 = 32 * nb;
#pragma unroll 8
    for (int i = 0; i < 32; ++i) { const int kk = 2 * i + (lane >> 5); scr[kk * 33 + (lane & 31)] = W[(size_t)(k0 + kk) * N + n0 + (lane & 31)]; }
    LDS_WAIT(); asm volatile("" ::: "memory");
#pragma unroll
    for (int j = 0; j < 2; ++j) { const int cid = lane + 64 * j, n = cid >> 2, c = cid & 3; const LAS float* s = scr + (16 * c) * 33 + n;
        v4u o;
        o.x = (unsigned)pk4_fp8(sat8(s[0 * 33] * scale), sat8(s[1 * 33] * scale), sat8(s[2 * 33] * scale), sat8(s[3 * 33] * scale));
        o.y = (unsigned)pk4_fp8(sat8(s[4 * 33] * scale), sat8(s[5 * 33] * scale), sat8(s[6 * 33] * scale), sat8(s[7 * 33] * scale));
        o.z = (unsigned)pk4_fp8(sat8(s[8 * 33] * scale), sat8(s[9 * 33] * scale), sat8(s[10 * 33] * scale), sat8(s[11 * 33] * scale));
        o.w = (unsigned)pk4_fp8(sat8(s[12 * 33] * scale), sat8(s[13 * 33] * scale), sat8(s[14 * 33] * scale), sat8(s[15 * 33] * scale));
        *(GAS v4u*)(WT8 + (size_t)(n0 + n) * K + k0 + 16 * c) = o; }
    LDS_WAIT(); asm volatile("" ::: "memory");
}
DEV void p0_tr8_item(const float* W, int K, int N, unsigned char* WT8, int item, int lane, float scale, int NC = 0, bool qkperm = false) {
    const int nblk = (NC ? NC : N) / 64, kb = item / nblk, nb = item % nblk, k0 = 128 * kb, n0 = 64 * nb, lg = lane >> 4, lc = lane & 15;
    const float* src = W + (size_t)(k0 + 32 * lg) * N + n0 + 4 * lc;
    f32x4 v[32];
#pragma unroll
    for (int i = 0; i < 32; ++i) v[i] = __builtin_nontemporal_load((const GAS f32x4*)(src + (size_t)i * N));
#pragma unroll
    for (int j = 0; j < 4; ++j) { unsigned w[8];
#pragma unroll
        for (int q = 0; q < 8; ++q) w[q] = (unsigned)pk4_fp8(sat8(v[4 * q][j] * scale), sat8(v[4 * q + 1][j] * scale), sat8(v[4 * q + 2][j] * scale), sat8(v[4 * q + 3][j] * scale));
        int nrow = n0 + 4 * lc + j; if (qkperm && nrow < 2048) { const int c = nrow & 255; nrow = (nrow & ~255) + 128 * ((c >> 5) & 1) + 32 * (c >> 6) + (c & 31); }
        GAS v4u* dst = (GAS v4u*)(WT8 + (size_t)nrow * K + k0 + 32 * lg);
        dst[0] = (v4u){w[0], w[1], w[2], w[3]}; dst[1] = (v4u){w[4], w[5], w[6], w[7]}; }
}
DEV void p0_tr16_item(const float* W, int K, int N, bf16* WT, int item, int lane, int NC, bool qkperm) {
    const int nblk = NC / 64, kb = item / nblk, nb = item % nblk, k0 = 128 * kb, n0 = 64 * nb, lg = lane >> 4, lc = lane & 15;
    const float* src = W + (size_t)(k0 + 32 * lg) * N + n0 + 4 * lc;
    f32x4 v[32];
#pragma unroll
    for (int i = 0; i < 32; ++i) v[i] = *(const GAS f32x4*)(src + (size_t)i * N);
#pragma unroll
    for (int j = 0; j < 4; ++j) {
        int nrow = n0 + 4 * lc + j; if (qkperm && nrow < 2048) { const int c = nrow & 255; nrow = (nrow & ~255) + 128 * ((c >> 5) & 1) + 32 * (c >> 6) + (c & 31); }
        GAS v4u* dst = (GAS v4u*)(WT + (size_t)nrow * K + k0 + 32 * lg);
#pragma unroll
        for (int q = 0; q < 4; ++q) { v4u o; o.x = pk2(v[8 * q][j], v[8 * q + 1][j]); o.y = pk2(v[8 * q + 2][j], v[8 * q + 3][j]); o.z = pk2(v[8 * q + 4][j], v[8 * q + 5][j]); o.w = pk2(v[8 * q + 6][j], v[8 * q + 7][j]); dst[q] = o; }
    }
}
DEV void p0_tr8_item_h(const float* W, int K, int N, unsigned char* WT8, int item, int lane, float scale) {
    const int nblk = N / 64, kb = item / nblk, nb = item % nblk, k0 = 128 * kb, n0 = 64 * nb, lg = lane >> 4, lc = lane & 15;
#pragma unroll 1
    for (int hf = 0; hf < 2; ++hf) {
        const float* src = W + (size_t)(k0 + 32 * lg + 16 * hf) * N + n0 + 4 * lc;
        f32x4 v[16];
#pragma unroll
        for (int i = 0; i < 16; ++i) v[i] = __builtin_nontemporal_load((const GAS f32x4*)(src + (size_t)i * N));
#pragma unroll
        for (int j = 0; j < 4; ++j) { v4u o;
            o.x = (unsigned)pk4_fp8(sat8(v[0][j] * scale), sat8(v[1][j] * scale), sat8(v[2][j] * scale), sat8(v[3][j] * scale)); o.y = (unsigned)pk4_fp8(sat8(v[4][j] * scale), sat8(v[5][j] * scale), sat8(v[6][j] * scale), sat8(v[7][j] * scale));
            o.z = (unsigned)pk4_fp8(sat8(v[8][j] * scale), sat8(v[9][j] * scale), sat8(v[10][j] * scale), sat8(v[11][j] * scale)); o.w = (unsigned)pk4_fp8(sat8(v[12][j] * scale), sat8(v[13][j] * scale), sat8(v[14][j] * scale), sat8(v[15][j] * scale));
            *(GAS v4u*)(WT8 + (size_t)(n0 + 4 * lc + j) * K + k0 + 32 * lg + 16 * hf) = o; }
    }
}
namespace pg8 {
template <int K, int N, int NSL, int IPS> struct ConvOrder : StaticOrder {
    const float* const __attribute__((address_space(4)))* wsrc; unsigned char* const __attribute__((address_space(4)))* wsp; size_t wsoff; int ub; mutable int ucount;
    __device__ __forceinline__ void done(const Unit&) const {
        const int gi = ub + ucount; ++ucount;
        if (gi >= 0 && (gi & 3) == 0 && (gi >> 2) < NSL) { constexpr int per_e = (K / 128) * (N / 64); const int s = gi >> 2;
            int tx = threadIdx.x; asm volatile("" : "+v"(tx) :: "memory");
            const int lane = tx & 63, gw = blockIdx.x * 8 + __builtin_amdgcn_readfirstlane(tx >> 6), NGW = gridDim.x * 8;
            const float* W = *wsrc; unsigned char* WT8 = *wsp + wsoff;
            for (int k = s * IPS; k < (s + 1) * IPS; ++k) { const int it = gw + k * NGW; if (it < NE * per_e) { const int e = it / per_e;
                p0_tr8_item_h(W + (size_t)e * K * N, K, N, WT8 + (size_t)e * K * N, it % per_e, lane, 512.0f); } } }
    }
};
template <int K, int N, int NSL, int IPS> struct GatherOrder : ConvOrder<K, N, NSL, IPS> {
    static constexpr bool GATHER = true;
    PG8_LAS unsigned char* ldsb;
    __device__ __forceinline__ void fill(int slot, int pm) const {
        const int tid = threadIdx.x;
        if (tid < 256) { const PG8_LAS int* pads = (const PG8_LAS int*)(ldsb + PADS_OFF); const PG8_LAS int* cl = (const PG8_LAS int*)(ldsb + CNTL_OFF);
            const __attribute__((address_space(4))) unsigned long long* kp = (const __attribute__((address_space(4))) unsigned long long*)__builtin_amdgcn_kernarg_segment_ptr();
            const int* tok_by_e = (const int*)((const unsigned char*)kp[30] + WS_ROUTE) + 3 * T * TOPK;
            const int e = this->texp[pm], idx = pm * 256 + tid - pads[e]; ((PG8_LAS int*)(ldsb + TOKT_OFF))[slot * 256 + tid] = idx < cl[e] ? tok_by_e[(size_t)e * T + idx] : 0; }
    }
    __device__ __forceinline__ int tokrow(int slot, int row) const { return ((const PG8_LAS int*)(ldsb + TOKT_OFF))[slot * 256 + row]; }
    __device__ __forceinline__ void gather_init(const Unit& u) const {
        fill(0, u.pm); Unit u1; if (this->next(1, u1)) fill(1, u1.pm); asm volatile("s_waitcnt vmcnt(0) lgkmcnt(0)" ::: "memory"); __builtin_amdgcn_s_barrier(); asm volatile("" ::: "memory");
    }
    __device__ __forceinline__ void done(const Unit& u) const {
        const int n = this->ucount;
        ConvOrder<K, N, NSL, IPS>::done(u);
        Unit u2; if (this->next(n + 2, u2)) fill(u2.slot, u2.pm);
    }
};
}
DEV void rms_row_to_bf16(const float* xrow, const float* gain, bf16* orow, unsigned char* orow8, int lane) {
    const GAS f32x4* xr = (const GAS f32x4*)xrow + lane; const GAS f32x4* gr = (const GAS f32x4*)gain + lane;
    f32x4 v[8]; float s = 0.f;
#pragma unroll
    for (int j = 0; j < 8; ++j) { v[j] = xr[64 * j]; s += (v[j].x * v[j].x + v[j].y * v[j].y) + (v[j].z * v[j].z + v[j].w * v[j].w); }
    const float rstd = 1.0f / sqrtf(wave_sum(s) * (1.f / D) + RMS_EPS);
    GAS v2u* o8 = (GAS v2u*)orow + lane;
#pragma unroll
    for (int j = 0; j < 8; ++j) { const f32x4 g = gr[64 * j]; const float a = v[j].x * rstd * g.x, b = v[j].y * rstd * g.y, c = v[j].z * rstd * g.z, d = v[j].w * rstd * g.w; v2u o; o.x = pk2(a, b); o.y = pk2(c, d); if (orow) o8[64 * j] = o;
        ((GAS unsigned*)orow8 + lane)[64 * j] = (unsigned)pk4_fp8(sat8(16.0f * a), sat8(16.0f * b), sat8(16.0f * c), sat8(16.0f * d)); }
}


typedef float f32x16 __attribute__((ext_vector_type(16)));
typedef short bf16x8 __attribute__((ext_vector_type(8)));
typedef short s16x4 __attribute__((ext_vector_type(4)));
typedef float f32x2_t __attribute__((ext_vector_type(2))); typedef __bf16 bf16x2_t __attribute__((ext_vector_type(2)));
constexpr float LOG2E = 1.4426950408889634f;
constexpr int AT_STAGE = 32768, AT_LUT = 2 * AT_STAGE, AT_LSC = AT_LUT + 1280, AT_BYTES = AT_LSC + 2048;
DEV unsigned off_a(unsigned row, unsigned ch) { return 2048u * (row >> 3) + 512u * (ch >> 2) + 64u * (row & 7) + 16u * ((ch & 3) ^ ((row >> 2) & 3)); }
DEV unsigned cvtpk_s(float lo, float hi) { f32x2_t v = {lo, hi}; bf16x2_t b = __builtin_convertvector(v, bf16x2_t); return __builtin_bit_cast(unsigned, b); }
DEV s16x4 vtr(const LAS unsigned char* p) { return __builtin_bit_cast(s16x4, __builtin_amdgcn_ds_read_tr16_b64_v4i16((LAS s16x4*)p)); }
DEV bf16x8 pack8(const f32x16& x, int s) {
    v4u p; p.x = cvtpk_s(x[8 * s], x[8 * s + 1]); p.y = cvtpk_s(x[8 * s + 2], x[8 * s + 3]); p.z = cvtpk_s(x[8 * s + 4], x[8 * s + 5]); p.w = cvtpk_s(x[8 * s + 6], x[8 * s + 7]);
    return __builtin_bit_cast(bf16x8, p);
}
#define MFMA32(a, b, c) __builtin_amdgcn_mfma_f32_32x32x16_bf16((a), (b), (c), 0, 0, 0)

DEV void attn_unit(LAS unsigned char* lds, int b, int h, int qblk, const bf16* Qb, const bf16* Kb, const bf16* Vb, int vpitch, bf16* OAB,
                   const float* table, const float* sub_gain, float lam, float shift, int tid, int lane, int wave) {
    asm volatile("" : "+v"(lane), "+v"(tid));
    const int r = lane & 31, hh = lane >> 5;
    const int q0w = 256 * qblk + 32 * wave;
    const int cq = q0w >> 6;
    const int ntile = 4 * qblk + 4;
    const size_t rowb = (size_t)b * SEQ;
    LAS float* lut = (LAS float*)(lds + AT_LUT);
    for (int i = tid; i < 320; i += NTHR) lut[i] = table[t5_bucket(i - 255) * 8 + h] * LOG2E - shift;
    bf16x8 qf[2][4];
    { const bf16* qrow = Qb + (rowb + q0w + r) * (size_t)vpitch + h * 128 + 8 * hh;
#pragma unroll
      for (int mm = 0; mm < 2; ++mm)
#pragma unroll
          for (int ks = 0; ks < 4; ++ks) qf[mm][ks] = *(const bf16x8*)(qrow + mm * 64 + 16 * ks); }
    const int srow = 8 * wave + ((lane & 31) >> 2), sch = 4 * (lane >> 5) + ((lane & 3) ^ ((srow >> 2) & 3));
    const bf16* kg = Kb + (rowb + srow) * (size_t)vpitch + h * 128 + sch * 8;
    const bf16* vg = Vb + (rowb + srow) * (size_t)vpitch + h * 128 + sch * 8;
    const int sdst = 2048 * wave;
#define AT_G16(gp, ldsoff) do { unsigned keep_; asm volatile("s_mov_b32 %0, m0\n\ts_mov_b32 m0, %2\n\ts_nop 0\n\tglobal_load_lds_dwordx4 %1, off\n\ts_mov_b32 m0, %0" : "=&s"(keep_) : "v"(gp), "s"(ldsoff) : "memory"); } while (0)
#define AT_DMA(j, buf) do { const unsigned sb_ = (unsigned)__builtin_amdgcn_readfirstlane((int)(unsigned)(unsigned long)(lds + (buf) * AT_STAGE + sdst)); \
        AT_G16(kg + (size_t)(j) * 64 * vpitch, sb_); AT_G16(kg + (size_t)(j) * 64 * vpitch + 64, sb_ + 1024u); \
        AT_G16(vg + (size_t)(j) * 64 * vpitch, sb_ + 16384u); AT_G16(vg + (size_t)(j) * 64 * vpitch + 64, sb_ + 16384u + 1024u); } while (0)
    AT_DMA(0, 0);
    VM_WAIT();
#pragma unroll
    for (int mm = 0; mm < 2; ++mm)
#pragma unroll
        for (int ks = 0; ks < 4; ++ks) asm volatile("" : "+v"(qf[mm][ks]));
    __syncthreads();
    f32x16 O[2][4];
#pragma unroll
    for (int mm = 0; mm < 2; ++mm)
#pragma unroll
        for (int d = 0; d < 4; ++d)
#pragma unroll
            for (int i = 0; i < 16; ++i) O[mm][d][i] = 0.f;
    float ls0 = 0.f, ls1 = 0.f;
    unsigned kad0, kad1, vad0, vad1;
    { const int blk = (lane >> 4) & 1, tq = (lane & 15) >> 2, tp = lane & 3;
      kad0 = off_a(r, hh); kad1 = off_a(r, 2 + hh);
      vad0 = off_a(4 * hh + tq, 2 * blk + (tp >> 1)) + 8 * (tp & 1); vad1 = off_a(8 + 4 * hh + tq, 2 * blk + (tp >> 1)) + 8 * (tp & 1); }
    for (int j = 0; j < ntile; ++j) {
        const bool more = (j + 1 < ntile);
        if (more) AT_DMA(j + 1, (j + 1) & 1);
        if (j <= cq) {
            const LAS unsigned char* Ks = lds + (j & 1) * AT_STAGE; const LAS unsigned char* Vs = Ks + 16384;
            const bool nearb = (j + 2 >= cq);
#pragma unroll 1
            for (int kb = 0; kb < 2; ++kb) {
                bf16x8 pf[2][2];
#pragma unroll
                for (int mm = 0; mm < 2; ++mm) {
                    f32x16 sa;
                    if (nearb) { const int base = 64 * j + 32 * kb + 4 * hh - q0w - r + 255;
#pragma unroll
                        for (int i = 0; i < 16; ++i) sa[i] = lut[base + (i & 3) + 8 * (i >> 2)]; }
                    else { const float cfar = lut[0];
#pragma unroll
                        for (int i = 0; i < 16; ++i) sa[i] = cfar; }
#pragma unroll
                    for (int ks = 0; ks < 4; ++ks) {
                        const bf16x8 kf = *(const LAS bf16x8*)(Ks + 8192 * kb + ((ks & 1) ? kad1 : kad0) + 512 * (2 * mm + (ks >> 1)));
                        sa = MFMA32(kf, qf[mm][ks], sa);
                        if (ks == 1) __builtin_amdgcn_sched_barrier(0);
                    }
                    float lacc = 0.f;
#pragma unroll
                    for (int i = 0; i < 16; ++i) { sa[i] = __builtin_amdgcn_exp2f(sa[i]); lacc += sa[i]; }
                    if (mm == 0) ls0 += lacc; else ls1 += lacc;
                    pf[mm][0] = pack8(sa, 0); pf[mm][1] = pack8(sa, 1);
                }
#pragma unroll
                for (int s = 0; s < 2; ++s)
#pragma unroll
                    for (int d = 0; d < 4; ++d) {
                        const s16x4 lo = vtr(Vs + 8192 * kb + vad0 + 4096 * s + 512 * d);
                        const s16x4 hi = vtr(Vs + 8192 * kb + vad1 + 4096 * s + 512 * d);
                        const bf16x8 vf = __builtin_shufflevector(lo, hi, 0, 1, 2, 3, 4, 5, 6, 7);
                        O[0][d] = MFMA32(pf[0][s], vf, O[0][d]); O[1][d] = MFMA32(pf[1][s], vf, O[1][d]);
                        if (d == 1 || d == 3) __builtin_amdgcn_sched_barrier(0);
                    }
            }
        }
        VM_WAIT();
        __syncthreads();
    }
#undef AT_DMA
#undef AT_G16
    ls0 += __shfl_xor(ls0, 32); ls1 += __shfl_xor(ls1, 32);
    LAS float* lsc = (LAS float*)(lds + AT_LSC) + wave * 64;
    if (hh == 0) { lsc[r] = 1.0f / ls0; lsc[32 + r] = lam / ls1; }
    LDS_WAIT(); asm volatile("" ::: "memory");
    float sg[4];
#pragma unroll
    for (int d = 0; d < 4; ++d) sg[d] = sub_gain[32 * d + r] * 0.8f;
#pragma unroll
    for (int i = 0; i < 16; ++i) {
        const int q = (i & 3) + 8 * (i >> 2) + 4 * hh; const float a0 = lsc[q], a1 = lsc[32 + q];
        float o[4]; float ss = 0.f;
#pragma unroll
        for (int d = 0; d < 4; ++d) { o[d] = O[0][d][i] * a0 - O[1][d][i] * a1; ss += o[d] * o[d]; }
        ss += __shfl_xor(ss, 1); ss += __shfl_xor(ss, 2); ss += __shfl_xor(ss, 4); ss += __shfl_xor(ss, 8); ss += __shfl_xor(ss, 16);
        const float rstd = 1.0f / sqrtf(ss * (1.f / 128.f) + RMS_EPS);
        bf16* orow = OAB + (rowb + q0w + q) * 2048 + h * 128 + r;
#pragma unroll
        for (int d = 0; d < 4; ++d) orow[32 * d] = (bf16)f2bf(o[d] * rstd * sg[d]);
    }
    __syncthreads();
}

constexpr int AT3_QS = 65536, AT3_LUT = TOKT_OFF + 3072;
DEV void attn_unit3(LAS unsigned char* lds, int b, int h, int qblk, const bf16* Qb, const bf16* Kb, const bf16* Vb, int vpitch, bf16* OAB,
                   const float* table, const float* sub_gain, float lam, float shift, int tid, int lane, int wave) {
    asm volatile("" : "+v"(lane), "+v"(tid));
    const int r = lane & 31, hh = lane >> 5;
    const int q0w = 256 * qblk + 32 * wave;
    const int cq = q0w >> 6;
    const int ntile = 4 * qblk + 4;
    const size_t rowb = (size_t)b * SEQ;
    LAS float* lut = (LAS float*)(lds + AT3_LUT);
    for (int i = tid; i < 320; i += NTHR) lut[i] = table[t5_bucket(i - 255) * 8 + h] * LOG2E - shift;
    LAS unsigned char* qpark = lds + AT3_QS + wave * 8192 + lane * 16;
    { const bf16* qrow = Qb + (rowb + q0w + r) * (size_t)vpitch + h * 128 + 8 * hh;
#pragma unroll
      for (int mm = 0; mm < 2; ++mm)
#pragma unroll
          for (int ks = 0; ks < 4; ++ks) *(LAS bf16x8*)(qpark + (mm * 4 + ks) * 1024) = *(const bf16x8*)(qrow + mm * 64 + 16 * ks); }
    const int srow = 8 * wave + ((lane & 31) >> 2), sch = 4 * (lane >> 5) + ((lane & 3) ^ ((srow >> 2) & 3));
    const unsigned goff = (unsigned)(((size_t)srow * vpitch + h * 128 + sch * 8) * 2);
    const unsigned long long kbase = (unsigned long long)(Kb + rowb * (size_t)vpitch), vbase = (unsigned long long)(Vb + rowb * (size_t)vpitch);
    const int sdst = 2048 * wave;
#define AT_G16(sbase, ldsoff) do { unsigned keep_; asm volatile("s_mov_b32 %0, m0\n\ts_mov_b32 m0, %2\n\ts_nop 0\n\tglobal_load_lds_dwordx4 %1, %3\n\ts_mov_b32 m0, %4\n\ts_nop 0\n\tglobal_load_lds_dwordx4 %1, %5\n\ts_mov_b32 m0, %0" \
        : "=&s"(keep_) : "v"(goff), "s"(ldsoff), "s"(sbase), "s"((ldsoff) + 1024u), "s"((sbase) + 128ull) : "memory"); } while (0)
#define AT_DMA(j, buf) do { const unsigned sb_ = (unsigned)__builtin_amdgcn_readfirstlane((int)(unsigned)(unsigned long)(lds + (buf) * AT_STAGE + sdst)); \
        const unsigned long long tb_ = (unsigned long long)(j) * 64ull * (unsigned long long)vpitch * 2ull; \
        AT_G16(kbase + tb_, sb_); AT_G16(vbase + tb_, sb_ + 16384u); } while (0)
    AT_DMA(0, 0);
    VM_WAIT();
    __syncthreads();
    f32x16 O[2][4];
#pragma unroll
    for (int mm = 0; mm < 2; ++mm)
#pragma unroll
        for (int d = 0; d < 4; ++d)
#pragma unroll
            for (int i = 0; i < 16; ++i) O[mm][d][i] = 0.f;
    float ls0 = 0.f, ls1 = 0.f;
    unsigned kad0, vad0;
    { const int blk = (lane >> 4) & 1, tq = (lane & 15) >> 2, tp = lane & 3;
      kad0 = off_a(r, hh);
      vad0 = off_a(4 * hh + tq, 2 * blk + (tp >> 1)) + 8 * (tp & 1); }
#define kad1 (kad0 ^ 32u)
#define vad1 ((vad0 ^ 32u) + 2048u)
    for (int j = 0; j < ntile; ++j) {
        const bool more = (j + 1 < ntile);
        if (more) AT_DMA(j + 1, (j + 1) & 1);
        if (j <= cq) {
            const LAS unsigned char* Ks = lds + (j & 1) * AT_STAGE; const LAS unsigned char* Vs = Ks + 16384;
            const bool nearb = (j + 2 >= cq);
            f32x16 S[2][2];
#pragma unroll
            for (int kb = 0; kb < 2; ++kb) {
                if (nearb) { const int base = 64 * j + 32 * kb + 4 * hh - q0w - r + 255;
#pragma unroll
                    for (int i = 0; i < 16; ++i) { const float bv = lut[base + (i & 3) + 8 * (i >> 2)]; S[kb][0][i] = bv; S[kb][1][i] = bv; } }
                else { const float cfar = lut[0];
#pragma unroll
                    for (int i = 0; i < 16; ++i) { S[kb][0][i] = cfar; S[kb][1][i] = cfar; } }
            }
#pragma unroll
            for (int ks = 0; ks < 4; ++ks) {
                const bf16x8 q0 = *(const LAS bf16x8*)(qpark + ks * 1024), q1 = *(const LAS bf16x8*)(qpark + (4 + ks) * 1024);
#pragma unroll
                for (int kb = 0; kb < 2; ++kb) {
                    const bf16x8 k0 = *(const LAS bf16x8*)(Ks + 8192 * kb + ((ks & 1) ? kad1 : kad0) + 512 * (ks >> 1));
                    const bf16x8 k1 = *(const LAS bf16x8*)(Ks + 8192 * kb + ((ks & 1) ? kad1 : kad0) + 512 * (2 + (ks >> 1)));
                    S[kb][0] = MFMA32(k0, q0, S[kb][0]); S[kb][1] = MFMA32(k1, q1, S[kb][1]);
                    __builtin_amdgcn_sched_barrier(0);
                }
                __builtin_amdgcn_sched_barrier(0);
            }
            bf16x8 pf[2][2][2];
#pragma unroll
            for (int kb = 0; kb < 2; ++kb)
#pragma unroll
                for (int mm = 0; mm < 2; ++mm) { float lacc = 0.f;
#pragma unroll
                    for (int i = 0; i < 16; ++i) { S[kb][mm][i] = __builtin_amdgcn_exp2f(S[kb][mm][i]); lacc += S[kb][mm][i]; }
                    if (mm == 0) ls0 += lacc; else ls1 += lacc;
                    pf[kb][mm][0] = pack8(S[kb][mm], 0); pf[kb][mm][1] = pack8(S[kb][mm], 1);
                    __builtin_amdgcn_sched_barrier(0); }
            __builtin_amdgcn_sched_barrier(0);
#pragma unroll
            for (int kb = 0; kb < 2; ++kb)
#pragma unroll
                for (int s = 0; s < 2; ++s)
#pragma unroll
                    for (int d = 0; d < 4; ++d) {
                        const s16x4 lo = vtr(Vs + 8192 * kb + vad0 + 4096 * s + 512 * d);
                        const s16x4 hi = vtr(Vs + 8192 * kb + vad1 + 4096 * s + 512 * d);
                        const bf16x8 vf = __builtin_shufflevector(lo, hi, 0, 1, 2, 3, 4, 5, 6, 7);
                        O[0][d] = MFMA32(pf[kb][0][s], vf, O[0][d]); O[1][d] = MFMA32(pf[kb][1][s], vf, O[1][d]);
                        __builtin_amdgcn_sched_barrier(0);
                    }
        }
        VM_WAIT();
        __syncthreads();
    }
#undef AT_DMA
#undef kad1
#undef vad1
#undef AT_G16
    ls0 += __shfl_xor(ls0, 32); ls1 += __shfl_xor(ls1, 32);
    LAS float* lsc = (LAS float*)(lds + AT3_QS) + wave * 2048;
    if (hh == 0) { lsc[r] = 1.0f / ls0; lsc[32 + r] = lam / ls1; }
    LDS_WAIT(); asm volatile("" ::: "memory");
    float sg[4];
#pragma unroll
    for (int d = 0; d < 4; ++d) sg[d] = sub_gain[32 * d + r] * 0.8f;
#pragma unroll
    for (int i = 0; i < 16; ++i) {
        const int q = (i & 3) + 8 * (i >> 2) + 4 * hh; const float a0 = lsc[q], a1 = lsc[32 + q];
        float o[4]; float ss = 0.f;
#pragma unroll
        for (int d = 0; d < 4; ++d) { o[d] = O[0][d][i] * a0 - O[1][d][i] * a1; ss += o[d] * o[d]; }
#define AT_DPPF(v_, ctrl_) __builtin_bit_cast(float, __builtin_amdgcn_update_dpp(0, __builtin_bit_cast(int, (float)(v_)), ctrl_, 0xf, 0xf, true))
        ss += AT_DPPF(ss, 0xB1); ss += AT_DPPF(ss, 0x4E); ss += AT_DPPF(ss, 0x141); ss += AT_DPPF(ss, 0x140); ss += __shfl_xor(ss, 16);
#undef AT_DPPF
        const float rstd = __builtin_amdgcn_rsqf(ss * (1.f / 128.f) + RMS_EPS);
        bf16* orow = OAB + (rowb + q0w + q) * 2048 + h * 128 + r;
#pragma unroll
        for (int d = 0; d < 4; ++d) orow[32 * d] = (bf16)f2bf(o[d] * rstd * sg[d]);
        __builtin_amdgcn_sched_barrier(0);
    }
    __syncthreads();
}

constexpr int AT4_QS = 98304;
DEV void attn_unit4(LAS unsigned char* lds, int b, int h, int qblk, const bf16* Qb, const bf16* Kb, const bf16* Vb, int vpitch, bf16* OAB,
                   const float* table, const float* sub_gain, float lam, float shift, int tid, int lane, int wave) {
    asm volatile("" : "+v"(lane), "+v"(tid));
    const int r = lane & 31, hh = lane >> 5;
    const int q0w = 256 * qblk + 32 * wave;
    const int cq = q0w >> 6;
    const int ntile = 4 * qblk + 4;
    const size_t rowb = (size_t)b * SEQ;
    LAS float* lut = (LAS float*)(lds + AT3_LUT);
    for (int i = tid; i < 320; i += NTHR) lut[i] = table[t5_bucket(i - 255) * 8 + h] * LOG2E - shift;
    bf16x8 qf[4];
    LAS unsigned char* qpark = lds + AT4_QS + wave * 4096 + lane * 16;
    { const bf16* qrow = Qb + (rowb + q0w + r) * (size_t)vpitch + h * 128 + 8 * hh;
#pragma unroll
      for (int ks = 0; ks < 4; ++ks) { qf[ks] = *(const bf16x8*)(qrow + 16 * ks); *(LAS bf16x8*)(qpark + ks * 1024) = *(const bf16x8*)(qrow + 64 + 16 * ks); } }
    const int srow = 8 * wave + ((lane & 31) >> 2), sch = 4 * (lane >> 5) + ((lane & 3) ^ ((srow >> 2) & 3));
    const unsigned goff = (unsigned)(((size_t)srow * vpitch + h * 128 + sch * 8) * 2);
    const unsigned long long kbase = (unsigned long long)(Kb + rowb * (size_t)vpitch), vbase = (unsigned long long)(Vb + rowb * (size_t)vpitch);
    const int sdst = 2048 * wave;
#define AT_G16(sbase, ldsoff) do { unsigned keep_; asm volatile("s_mov_b32 %0, m0\n\ts_mov_b32 m0, %2\n\ts_nop 0\n\tglobal_load_lds_dwordx4 %1, %3\n\ts_mov_b32 m0, %4\n\ts_nop 0\n\tglobal_load_lds_dwordx4 %1, %5\n\ts_mov_b32 m0, %0" \
        : "=&s"(keep_) : "v"(goff), "s"(ldsoff), "s"(sbase), "s"((ldsoff) + 1024u), "s"((sbase) + 128ull) : "memory"); } while (0)
#define AT_DMA(j, buf) do { const unsigned sb_ = (unsigned)__builtin_amdgcn_readfirstlane((int)(unsigned)(unsigned long)(lds + ((j) % 3) * AT_STAGE + sdst)); \
        const unsigned long long tb_ = (unsigned long long)(j) * 64ull * (unsigned long long)vpitch * 2ull; \
        AT_G16(kbase + tb_, sb_); AT_G16(vbase + tb_, sb_ + 16384u); } while (0)
    AT_DMA(0, 0); if (ntile > 1) AT_DMA(1, 1);
    VM_WAIT();
#pragma unroll
    for (int ks = 0; ks < 4; ++ks) asm volatile("" : "+v"(qf[ks]));
    __syncthreads();
    f32x16 O[2][4];
#pragma unroll
    for (int mm = 0; mm < 2; ++mm)
#pragma unroll
        for (int d = 0; d < 4; ++d)
#pragma unroll
            for (int i = 0; i < 16; ++i) O[mm][d][i] = 0.f;
    float ls0 = 0.f, ls1 = 0.f;
    unsigned kad0, vad0;
    { const int blk = (lane >> 4) & 1, tq = (lane & 15) >> 2, tp = lane & 3;
      kad0 = off_a(r, hh);
      vad0 = off_a(4 * hh + tq, 2 * blk + (tp >> 1)) + 8 * (tp & 1); }
#define kad1 (kad0 ^ 32u)
#define vad1 ((vad0 ^ 32u) + 2048u)
    for (int j = 0; j < ntile; ++j) {
        const bool more2 = (j + 2 < ntile);
        if (more2) AT_DMA(j + 2, 0);
        if (j <= cq) {
            const LAS unsigned char* Ks = lds + (j % 3) * AT_STAGE; const LAS unsigned char* Vs = Ks + 16384;
            const bool nearb = (j + 2 >= cq);
#pragma unroll 1
            for (int kb = 0; kb < 2; ++kb) {
                f32x16 s0, s1;
                if (nearb) { const int base = 64 * j + 32 * kb + 4 * hh - q0w - r + 255;
#pragma unroll
                    for (int i = 0; i < 16; ++i) { const float bv = lut[base + (i & 3) + 8 * (i >> 2)]; s0[i] = bv; s1[i] = bv; } }
                else { const float cfar = lut[0];
#pragma unroll
                    for (int i = 0; i < 16; ++i) { s0[i] = cfar; s1[i] = cfar; } }
#pragma unroll
                for (int ks = 0; ks < 4; ++ks) {
                    const bf16x8 k0 = *(const LAS bf16x8*)(Ks + 8192 * kb + ((ks & 1) ? kad1 : kad0) + 512 * (ks >> 1));
                    s0 = MFMA32(k0, qf[ks], s0);
                }
                __builtin_amdgcn_sched_barrier(0);
#pragma unroll
                for (int ks = 0; ks < 4; ++ks) {
                    const bf16x8 k1 = *(const LAS bf16x8*)(Ks + 8192 * kb + ((ks & 1) ? kad1 : kad0) + 512 * (2 + (ks >> 1)));
                    s1 = MFMA32(k1, *(const LAS bf16x8*)(qpark + ks * 1024), s1);
#pragma unroll
                    for (int i = 4 * ks; i < 4 * ks + 4; ++i) { s0[i] = __builtin_amdgcn_exp2f(s0[i]); ls0 += s0[i]; }
                    __builtin_amdgcn_sched_barrier(0);
                }
                bf16x8 pf[2][2];
                pf[0][0] = pack8(s0, 0); pf[0][1] = pack8(s0, 1);
#pragma unroll
                for (int i = 0; i < 16; ++i) { s1[i] = __builtin_amdgcn_exp2f(s1[i]); ls1 += s1[i]; }
                pf[1][0] = pack8(s1, 0); pf[1][1] = pack8(s1, 1);
                __builtin_amdgcn_sched_barrier(0);
#pragma unroll
                for (int s = 0; s < 2; ++s)
#pragma unroll
                    for (int d = 0; d < 4; ++d) {
                        const s16x4 lo = vtr(Vs + 8192 * kb + vad0 + 4096 * s + 512 * d);
                        const s16x4 hi = vtr(Vs + 8192 * kb + vad1 + 4096 * s + 512 * d);
                        const bf16x8 vf = __builtin_shufflevector(lo, hi, 0, 1, 2, 3, 4, 5, 6, 7);
                        O[0][d] = MFMA32(pf[0][s], vf, O[0][d]); O[1][d] = MFMA32(pf[1][s], vf, O[1][d]);
                        if (d & 1) __builtin_amdgcn_sched_barrier(0);
                    }
            }
        }
        if (more2) asm volatile("s_waitcnt vmcnt(4)" ::: "memory"); else VM_WAIT();
        __syncthreads();
    }
#undef AT_DMA
#undef kad1
#undef vad1
#undef AT_G16
    ls0 += __shfl_xor(ls0, 32); ls1 += __shfl_xor(ls1, 32);
    LAS float* lsc = (LAS float*)(lds + AT4_QS) + wave * 1024;
    if (hh == 0) { lsc[r] = 1.0f / ls0; lsc[32 + r] = lam / ls1; }
    LDS_WAIT(); asm volatile("" ::: "memory");
    float sg[4];
#pragma unroll
    for (int d = 0; d < 4; ++d) sg[d] = sub_gain[32 * d + r] * 0.8f;
#pragma unroll
    for (int i = 0; i < 16; ++i) {
        const int q = (i & 3) + 8 * (i >> 2) + 4 * hh; const float a0 = lsc[q], a1 = lsc[32 + q];
        float o[4]; float ss = 0.f;
#pragma unroll
        for (int d = 0; d < 4; ++d) { o[d] = O[0][d][i] * a0 - O[1][d][i] * a1; ss += o[d] * o[d]; }
#define AT_DPPF(v_, ctrl_) __builtin_bit_cast(float, __builtin_amdgcn_update_dpp(0, __builtin_bit_cast(int, (float)(v_)), ctrl_, 0xf, 0xf, true))
        ss += AT_DPPF(ss, 0xB1); ss += AT_DPPF(ss, 0x4E); ss += AT_DPPF(ss, 0x141); ss += AT_DPPF(ss, 0x140); ss += __shfl_xor(ss, 16);
#undef AT_DPPF
        const float rstd = __builtin_amdgcn_rsqf(ss * (1.f / 128.f) + RMS_EPS);
        bf16* orow = OAB + (rowb + q0w + q) * 2048 + h * 128 + r;
#pragma unroll
        for (int d = 0; d < 4; ++d) orow[32 * d] = (bf16)f2bf(o[d] * rstd * sg[d]);
        __builtin_amdgcn_sched_barrier(0);
    }
    __syncthreads();
}


constexpr int LR_WT = 0, LR_X = 65536, LR_XP = 272, LR_CONST = 101376, LR_SUM = 105984, LR_PRE = 110080, LR_END = 115200;
static_assert(LR_END <= LDSCTL_OFF, "LRU LDS map");
DEV void lru_xload(v4u (&xw_)[5], const bf16* PROJ, int b, int g, int tc, int tid) {
    const size_t grow0 = (size_t)b * SEQ + 128 * tc;
#pragma unroll
    for (int k = 0; k < 5; ++k) { const int c = tid + NTHR * k, rho = c >> 4, ch = c & 15; xw_[k] = (v4u){0u, 0u, 0u, 0u};
        if (c < 131 * 16 && (tc > 0 || rho >= 3)) xw_[k] = *(const v4u*)(PROJ + (grow0 + rho - 3) * P5P + C_XL + g * 128 + ch * 8); }
}
DEV void lru_unit(LAS unsigned char* lds, int b, int g, int tc, const bf16* PROJ, const bf16* WL, const float* cw, const float* cb, const float* ba, const float* bxv, const float* lamp,
                  bf16* HL, bf16* PL, float* SP, float* SH, bool load_w, int tid, int lane, int wave, v4u (&xw_)[5], int nb, int ng, int ntc, bool has_next) {
    asm volatile("" : "+v"(lane), "+v"(tid));
    const int r = lane & 31, hh = lane >> 5, tb = wave & 3, chh = wave >> 2;
    const unsigned wad0 = off_a(r, hh), wad1 = off_a(r, 2 + hh);
    LAS float* cst = (LAS float*)(lds + LR_CONST);
    if (load_w) {
#pragma unroll
        for (int gate = 0; gate < 2; ++gate)
            for (int c = tid; c < 2048; c += NTHR) { const int row = c >> 4, ch = c & 15;
                const v4u w = *(const v4u*)(WL + ((size_t)((gate * 8 + g) * 128 + row)) * 128 + ch * 8); *(LAS v4u*)(lds + LR_WT + gate * 32768 + off_a(row, ch)) = w; }
        if (tid < 128) { const int gc = g * 128 + tid;
#pragma unroll
            for (int tap = 0; tap < 4; ++tap) cst[tap * 128 + tid] = cw[tap * 1024 + gc];
            cst[512 + tid] = cb[gc]; cst[640 + tid] = ba[gc]; cst[768 + tid] = bxv[gc];
            const float z = -lamp[gc]; const float sp = fmaxf(z, 0.f) + log1pf(__expf(-fabsf(z))); cst[896 + tid] = -8.0f * sp * LOG2E; }
    }
    const size_t grow0 = (size_t)b * SEQ + 128 * tc;
    {
#pragma unroll
      for (int k = 0; k < 5; ++k) { const int c = tid + NTHR * k, rho = c >> 4, ch = c & 15; if (c < 131 * 16) *(LAS v4u*)(lds + LR_X + rho * LR_XP + ch * 16) = xw_[k]; } }
    if (has_next) lru_xload(xw_, PROJ, nb, ng, ntc, tid);
    __syncthreads();
    const int tl = 32 * tb + r;
    bf16x8 xrf[8];
#pragma unroll
    for (int ks = 0; ks < 8; ++ks) {
        float v[8];
#pragma unroll
        for (int q = 0; q < 2; ++q) { const int cbase = 16 * ks + 8 * q + 4 * hh; f32x4 a = *(const LAS f32x4*)(cst + 512 + cbase);
#pragma unroll
            for (int tap = 0; tap < 4; ++tap) { const v2u xw = *(const LAS v2u*)(lds + LR_X + (tl + tap) * LR_XP + cbase * 2); const f32x4 w = *(const LAS f32x4*)(cst + tap * 128 + cbase);
                a.x += w.x * bf2f(xw.x & 0xffffu); a.y += w.y * bf2f(xw.x >> 16); a.z += w.z * bf2f(xw.y & 0xffffu); a.w += w.w * bf2f(xw.y >> 16); }
            v[4 * q] = a.x; v[4 * q + 1] = a.y; v[4 * q + 2] = a.z; v[4 * q + 3] = a.w; }
        v4u p; p.x = cvtpk_s(v[0], v[1]); p.y = cvtpk_s(v[2], v[3]); p.z = cvtpk_s(v[4], v[5]); p.w = cvtpk_s(v[6], v[7]);
        xrf[ks] = __builtin_bit_cast(bf16x8, p);
        __builtin_amdgcn_sched_barrier(0);
    }
    f32x16 acc[2][2];
    const LAS unsigned char* wbase = lds + LR_WT + 16384 * chh;
#pragma unroll
    for (int gate = 0; gate < 2; ++gate)
#pragma unroll
        for (int c2 = 0; c2 < 2; ++c2) {
#pragma unroll
            for (int i = 0; i < 16; ++i) acc[gate][c2][i] = 0.f;
#pragma unroll
            for (int ks = 0; ks < 8; ++ks) { const bf16x8 af = *(const LAS bf16x8*)(wbase + gate * 32768 + 8192 * c2 + 512 * (ks >> 1) + ((ks & 1) ? wad1 : wad0)); acc[gate][c2] = MFMA32(af, xrf[ks], acc[gate][c2]); }
            __builtin_amdgcn_sched_barrier(0);
        }
    const LAS float* cstw = cst + 64 * chh;
#pragma unroll
    for (int c2 = 0; c2 < 2; ++c2)
#pragma unroll
        for (int idx = 0; idx < 16; ++idx) {
            const int cl = 32 * c2 + (idx & 3) + 8 * (idx >> 2) + 4 * hh;
            const float rg = __builtin_amdgcn_rcpf(1.0f + __expf(-(acc[0][c2][idx] + cstw[640 + cl]))), ig = __builtin_amdgcn_rcpf(1.0f + __expf(-(acc[1][c2][idx] + cstw[768 + cl])));
            const float la2 = rg * cstw[896 + cl]; float a = __builtin_amdgcn_exp2f(la2); const float mult = __builtin_amdgcn_sqrtf(fmaxf(1.0f - __builtin_amdgcn_exp2f(2.0f * la2), 0.f));
            const int e = 4 * ((idx >> 2) & 1) + (idx & 3), k4 = 2 * c2 + (idx >> 3);
            const unsigned short xs = chh ? (unsigned short)xrf[4 + k4][e] : (unsigned short)xrf[k4][e];
            float hv = mult * ig * bf2f((unsigned)xs);
#define LR_DPP(oldv_, srcv_, ctrl_, rmask_) __builtin_bit_cast(float, __builtin_amdgcn_update_dpp(__builtin_bit_cast(int, (float)(oldv_)), __builtin_bit_cast(int, (float)(srcv_)), ctrl_, rmask_, 0xf, false))
#define LR_STEP(ctrl_, rmask_) do { const float ap_ = LR_DPP(1.0f, a, ctrl_, rmask_), hp_ = LR_DPP(0.0f, hv, ctrl_, rmask_); hv = a * hp_ + hv; a = a * ap_; } while (0)
            LR_STEP(0x111, 0xf); LR_STEP(0x112, 0xf); LR_STEP(0x114, 0xf); LR_STEP(0x118, 0xf); LR_STEP(0x142, 0xa);
#undef LR_STEP
#undef LR_DPP
            acc[0][c2][idx] = a; acc[1][c2][idx] = hv;
            if (idx & 1) __builtin_amdgcn_sched_barrier(0);
        }
    LAS float* sumP = (LAS float*)(lds + LR_SUM); LAS float* sumH = sumP + 512;
    if (r == 31) {
#pragma unroll
        for (int c2 = 0; c2 < 2; ++c2)
#pragma unroll
            for (int idx = 0; idx < 16; ++idx) { const int cl = 64 * chh + 32 * c2 + (idx & 3) + 8 * (idx >> 2) + 4 * hh; sumP[tb * 128 + cl] = acc[0][c2][idx]; sumH[tb * 128 + cl] = acc[1][c2][idx]; }
    }
    __syncthreads();
    LAS float* preP = (LAS float*)(lds + LR_PRE); LAS float* preH = preP + 640;
    if (tid < 128) { float Pc = 1.0f, Hc = 0.f;
        for (int w = 0; w < 4; ++w) { preP[w * 128 + tid] = Pc; preH[w * 128 + tid] = Hc; const float sp_ = sumP[w * 128 + tid]; Hc = sp_ * Hc + sumH[w * 128 + tid]; Pc *= sp_; }
        SP[(size_t)(b * 32 + tc) * 1024 + g * 128 + tid] = Pc; SH[(size_t)(b * 32 + tc) * 1024 + g * 128 + tid] = Hc; }
    __syncthreads();
    bf16* hrow = HL + (grow0 + tl) * 1024 + g * 128 + 64 * chh; bf16* prow = PL + (grow0 + tl) * 1024 + g * 128 + 64 * chh;
#pragma unroll
    for (int c2 = 0; c2 < 2; ++c2)
#pragma unroll
        for (int ip = 0; ip < 2; ++ip) { v2u hw[2], pw[2];
#pragma unroll
            for (int s2 = 0; s2 < 2; ++s2) { const int i4 = 2 * ip + s2, cl0 = 32 * c2 + 8 * i4 + 4 * hh; const f32x4 pp = *(const LAS f32x4*)(preP + tb * 128 + 64 * chh + cl0), ph = *(const LAS f32x4*)(preH + tb * 128 + 64 * chh + cl0);
                const float P0 = acc[0][c2][4 * i4], P1 = acc[0][c2][4 * i4 + 1], P2 = acc[0][c2][4 * i4 + 2], P3 = acc[0][c2][4 * i4 + 3];
                hw[s2].x = cvtpk_s(acc[1][c2][4 * i4] + P0 * ph.x, acc[1][c2][4 * i4 + 1] + P1 * ph.y); hw[s2].y = cvtpk_s(acc[1][c2][4 * i4 + 2] + P2 * ph.z, acc[1][c2][4 * i4 + 3] + P3 * ph.w);
                pw[s2].x = cvtpk_s(P0 * pp.x, P1 * pp.y); pw[s2].y = cvtpk_s(P2 * pp.z, P3 * pp.w); }
            { auto r0 = __builtin_amdgcn_permlane32_swap(hw[0].x, hw[1].x, false, false); auto r1 = __builtin_amdgcn_permlane32_swap(hw[0].y, hw[1].y, false, false);
              auto r2 = __builtin_amdgcn_permlane32_swap(pw[0].x, pw[1].x, false, false); auto r3 = __builtin_amdgcn_permlane32_swap(pw[0].y, pw[1].y, false, false);
              const int co = 32 * c2 + 16 * ip + 8 * hh;
              *(v4u*)(hrow + co) = (v4u){(unsigned)r0[0], (unsigned)r1[0], (unsigned)r0[1], (unsigned)r1[1]}; *(v4u*)(prow + co) = (v4u){(unsigned)r2[0], (unsigned)r3[0], (unsigned)r2[1], (unsigned)r3[1]}; } }
    __syncthreads();
}

struct Args { const float* in[29]; float* out; unsigned char* ws; int ph_lo, ph_hi; };
constexpr int NPHASE = 15;

DEV void moe_tiles(const unsigned* cnt_g, LAS unsigned char* lds, int tid) {
    LAS int* texp = (LAS int*)(lds + TEXP_OFF); LAS int* pads = (LAS int*)(lds + PADS_OFF); LAS int* cl = (LAS int*)(lds + CNTL_OFF); LAS int* nmt = (LAS int*)(lds + NMT_OFF); LAS int* arow = (LAS int*)(lds + AROW_OFF);
    __syncthreads();
    if (tid < 32) cl[tid] = (int)__hip_atomic_load(cnt_g + 64 * tid, RLX_AGENT);
    __syncthreads();
    if (tid == 0) {
        int nt = 0;
        for (int e = 0; e < NE; ++e) { const int c = cl[e]; const int ntile = (c + 255) >> 8; pads[e] = nt * 256; for (int i = 0; i < ntile; ++i) { texp[nt + i] = e; arow[nt + i] = e * T + 256 * i; } nt += ntile; }
        pads[NE] = nt * 256; nmt[0] = nt;
    }
    __syncthreads();
}

__global__ void __launch_bounds__(NTHR, 2) fwd_kernel(Args args) {
    extern __shared__ __attribute__((aligned(16))) unsigned char lds_raw[];
    LAS unsigned char* lds = (LAS unsigned char*)lds_raw;
    const int tid = threadIdx.x, lane = tid & 63, wave = __builtin_amdgcn_readfirstlane(tid >> 6);
    const int G = gridDim.x, bx = blockIdx.x;
    const int gw = bx * NWAVES + wave, NGW = G * NWAVES;
    const int gt = bx * NTHR + tid, NGT = G * NTHR;
    gu32* ctl = (gu32*)(args.ws + WS_CTL);
    for (int u = tid; u < (LDS_BYTES - LDSCTL_OFF) / 4; u += NTHR) ((LAS unsigned*)(lds + LDSCTL_OFF))[u] = 0u;
    __syncthreads();
    XcdBarrier bar = xcd_barrier_post((unsigned*)ctl + CW_BAR, (volatile LAS unsigned*)(lds + MISC_OFF));
    const int lo = args.ph_lo, hi = args.ph_hi;
#ifndef PHMASK
#define PHMASK 0x7fff
#endif
#define IN(k) ((((PHMASK) >> (k)) & 1) && lo <= (k) && (k) < hi)
#define SEAM(k) do { if (IN(k) && IN((k) + 1)) xcd_barrier(bar); } while (0)

    typedef const __attribute__((address_space(4))) Args* KArgs;
#define PH_PTRS KArgs ka = (KArgs)__builtin_amdgcn_kernarg_segment_ptr(); asm volatile("" : "+s"(ka)); unsigned char* ws = ka->ws; const float* x = ka->in[0]; bf16* WIN_T = (bf16*)(ws + WS_WIN); bf16* WA_T = (bf16*)(ws + WS_WA); bf16* WB_T = (bf16*)(ws + WS_WB); bf16* WOUT_T = (bf16*)(ws + WS_WOUT); bf16* W1_T = (bf16*)(ws + WS_W1); bf16* W2_T = (bf16*)(ws + WS_W2); bf16* Hb = (bf16*)(ws + WS_H); bf16* H8 = (bf16*)(ws + WS_XG);        bf16* PROJ = (bf16*)(ws + WS_PROJ); bf16* GT = (bf16*)(ws + WS_PROJ + 160 * MiB); bf16* Qb = (bf16*)(ws + WS_Q); bf16* Kb = (bf16*)(ws + WS_K); bf16* OAB = (bf16*)(ws + WS_OAB); bf16* HL = (bf16*)(ws + WS_LA); bf16* PL = (bf16*)(ws + WS_LA + 32 * MiB); float* SPs = (float*)(ws + WS_LU); float* SHs = (float*)(ws + WS_LU + 1 * MiB); bf16* WL = (bf16*)(ws + WS_WL); float* RSTD = (float*)(ws + WS_WL + 512 * 1024); float* RSS = (float*)(ws + WS_RSS); unsigned char* XGS = ws + WS_XGS; bf16* YA = (bf16*)(ws + WS_YA); bf16* YB = (bf16*)(ws + WS_YB); bf16* MIX = (bf16*)(ws + WS_MIX); bf16* H2 = (bf16*)(ws + WS_H2); bf16* XG = (bf16*)(ws + WS_XG); bf16* ACT = (bf16*)(ws + WS_ACT); bf16* EO = (bf16*)(ws + WS_EO); int* route_e = (int*)(ws + WS_ROUTE); int* route_rank = route_e + T * TOPK; float* route_gate = (float*)(route_rank + T * TOPK); int* tok_by_e = (int*)(route_gate + T * TOPK); unsigned* cnt_g = (unsigned*)ctl + CW_CNT; float* out = ka->out;

    constexpr int I_1 = (D / 128) * (HID / 64), I_2 = (FF / 128) * (D / 64);
#define CONV_W1() do { for (int it_ = gw; it_ < NE * I_1; it_ += NGW) { const int e_ = it_ / I_1; p0_tr8_item(ka->in[25] + (size_t)e_ * D * HID, D, HID, (unsigned char*)W1_T + (size_t)e_ * HID * D, it_ % I_1, lane, 512.0f); } } while (0)
#define CONV_W2() do { for (int it_ = gw; it_ < NE * I_2; it_ += NGW) { const int e_ = it_ / I_2; p0_tr8_item(ka->in[27] + (size_t)e_ * FF * D, FF, D, (unsigned char*)W2_T + (size_t)e_ * D * FF, it_ % I_2, lane, 512.0f); } } while (0)
    const bool conv_first = ((bx >> 3) & 1) != 0;

    if (IN(0)) { PH_PTRS;
        LAS float* scr = (LAS float*)(lds + RING_OFF + wave * 16384);
        constexpr int I_IN = 0, I_IN8 = (D / 128) * (INC / 64), I_A = (AW / 128) * (D / 64), I_O = (D / 128) * (D / 64);
        constexpr int NITEMS = I_IN + I_IN8 + 2 * I_A + I_O;
        for (int it = gw; it < NITEMS; it += NGW) {
            int r = it;
            if (r < I_IN8) { p0_tr8_item(ka->in[2], D, INC, (unsigned char*)WIN_T, r, lane, 512.0f, INC, true); continue; } r -= I_IN8;
            if (r < I_A) { p0_tr16_item(ka->in[19], AW, D, WA_T, r, lane, D, false); continue; } r -= I_A;
            if (r < I_A) { p0_tr16_item(ka->in[20], LW, D, WB_T, r, lane, D, false); continue; } r -= I_A;
            p0_tr16_item(ka->in[21], D, D, WOUT_T, r, lane, D, false);
        }
        for (int idx = gt; idx < 2 * 8 * 128 * 128; idx += NGT) {
            const int gate = idx >> 17, gg = (idx >> 14) & 7, j = (idx >> 7) & 127, p = idx & 127, ks = p >> 4, pp = p & 15, i = 16 * ks + 8 * ((pp >> 2) & 1) + 4 * (pp >> 3) + (pp & 3);
            WL[idx] = (bf16)f2bf((gate ? ka->in[16] : ka->in[14])[(size_t)(gg * 128 + i) * 128 + j]); }
#pragma unroll 4
        for (int m = gw; m < T; m += NGW) rms_row_to_bf16(x + (size_t)m * D, ka->in[1], nullptr, (unsigned char*)H8 + (size_t)m * D, lane);
    }
    SEAM(0);
    if (IN(1)) { PH_PTRS;
        { pg8::Gemm g{H8, WIN_T, T, INC, D, D, D}; pg8::ConvOrder<D, HID, 0, 8> S; S.init(T, INC, G, bx); S.wsrc = &ka->in[25]; S.wsp = &ka->ws; S.wsoff = WS_W1; S.ub = 0 - ((bx >> 3) & 3); S.ucount = 0;
          pg8::EpiProj E{PROJ, GT, ka->in[4], ka->in[5], ka->in[3], 0, 1.0f / 8192.0f};
          pg8::gemm_phase<pg8::EpiProj, pg8::ConvOrder<D, HID, 0, 8>, true, true, 1>(lds + RING_OFF, g, S, E); }
        for (int it_ = gw + 16 * NGW; it_ < NE * I_1; it_ += NGW) { const int e_ = it_ / I_1; p0_tr8_item_h(ka->in[25] + (size_t)e_ * D * HID, D, HID, (unsigned char*)W1_T + (size_t)e_ * HID * D, it_ % I_1, lane, 512.0f); }
    }
    SEAM(1);
    if (IN(3)) { PH_PTRS;
        float lam, shift;
        { const float a = wave_sum(ka->in[6][lane] * ka->in[7][lane]), b2_ = wave_sum(ka->in[8][lane] * ka->in[9][lane]); lam = __expf(a) - __expf(b2_) + 0.2f;
          const float gq = wave_max(fabsf(ka->in[4][lane])), gk = wave_max(fabsf(ka->in[5][lane]));
          const float* tb = ka->in[11]; const float mb = wave_max(fmaxf(fmaxf(fabsf(tb[lane]), fabsf(tb[64 + lane])), fmaxf(fabsf(tb[128 + lane]), fabsf(tb[192 + lane]))));
          shift = 11.5415603f * gq * gk + mb * LOG2E; }
        lam = __builtin_bit_cast(float, __builtin_amdgcn_readfirstlane(__builtin_bit_cast(int, lam))); shift = __builtin_bit_cast(float, __builtin_amdgcn_readfirstlane(__builtin_bit_cast(int, shift)));
        const int cls3 = (bx >> 3) & 3; int au = 0;
#define CONV_W1_S2() do { for (int k_ = 0; k_ < 16; ++k_) { const int it_ = gw + k_ * NGW; if (it_ < NE * I_1) { const int e_ = it_ / I_1; p0_tr8_item_h(ka->in[25] + (size_t)e_ * D * HID, D, HID, (unsigned char*)W1_T + (size_t)e_ * HID * D, it_ % I_1, lane, 512.0f); } } } while (0)
        if (cls3 == 0) CONV_W1_S2();
        for (int u = bx; u < 512; u += G, ++au) {
            if (au == 1 && cls3 == 1) CONV_W1_S2();
            const int v = u & 255, bh = v >> 3, qblk = (u < 256) ? (v & 7) : 15 - (v & 7);
            attn_unit4(lds + RING_OFF, bh >> 3, bh & 7, qblk, PROJ + C_Q, PROJ + C_K, PROJ + C_V, P5P, OAB, ka->in[11], ka->in[10], lam, shift, tid, lane, wave);
        }
    }
    if (IN(3)) { PH_PTRS; const int cls3 = (bx >> 3) & 3; if (cls3 >= 2 && cls3 == 2) CONV_W1_S2(); }
    if (IN(4)) { PH_PTRS;
        int i = 0; v4u xw_[5];
        if (bx < 1024) lru_xload(xw_, PROJ, (bx >> 3) >> 5, bx & 7, (bx >> 3) & 31, tid);
        for (int u = bx; u < 1024; u += G, ++i) {
            const int g = u & 7, bt = u >> 3, nu = u + G, nbt = nu >> 3;
            lru_unit(lds, bt >> 5, g, bt & 31, PROJ, WL, ka->in[12], ka->in[13], ka->in[15], ka->in[17], ka->in[18], HL, PL, SPs, SHs, (i == 0) || (G & 7) != 0, tid, lane, wave, xw_, nbt >> 5, nu & 7, nbt & 31, nu < 1024);
        }
        if (((bx >> 3) & 3) == 3) CONV_W1_S2();
    }
    SEAM(4);
    if (IN(5)) { PH_PTRS;
        for (int u = bx; u < 256; u += G) {
            const int b = u >> 6, tc = (u >> 1) & 31, hf = u & 1, c = 2 * tid;
            float hc0 = 0.f, hc1 = 0.f;
            for (int t2 = 0; t2 < tc; ++t2) { const float* sp = SPs + (size_t)(b * 32 + t2) * 1024 + c; const float* sh = SHs + (size_t)(b * 32 + t2) * 1024 + c; hc0 = sp[0] * hc0 + sh[0]; hc1 = sp[1] * hc1 + sh[1]; }
            for (int row = 0; row < 64; ++row) { const size_t t = (size_t)b * SEQ + 128 * tc + 64 * hf + row;
                const unsigned hw = *(const unsigned*)(HL + t * 1024 + c), pw = *(const unsigned*)(PL + t * 1024 + c), gl = *(const unsigned*)(PROJ + t * P5P + C_GL + c);
                const float h0 = bf2f(hw & 0xffffu) + bf2f(pw & 0xffffu) * hc0, h1 = bf2f(hw >> 16) + bf2f(pw >> 16) * hc1;
                *(unsigned*)(OAB + t * 2048 + 1024 + c) = pk2(h0 * bf2f(gl & 0xffffu), h1 * bf2f(gl >> 16));   }
        }
    }
    SEAM(6);
    if (IN(7)) { PH_PTRS;
        pg8::Gemm g{OAB, WA_T, T, D, AW, 2048, AW}; pg8::PairOrder S; S.init(T, D, G, bx); S.a1 = (size_t)1024 * 2; S.b1 = WS_WB - WS_WA;
        pg8::EpiMix2 E{MIX, (const unsigned char*)GT};
        pg8::gemm_phase<pg8::EpiMix2, pg8::PairOrder, true, true>(lds + RING_OFF, g, S, E);
    }
    SEAM(7);
    if (IN(9)) { PH_PTRS;
        pg8::Gemm g{MIX, WOUT_T, T, D, D, D, D}; pg8::StaticOrder S; S.init(T, D, G, bx);
        pg8::EpiBf16Res E{YB, x};
        pg8::gemm_phase<pg8::EpiBf16Res, pg8::StaticOrder, true, true>(lds + RING_OFF, g, S, E);
    }
    SEAM(9);
    if (IN(10)) { PH_PTRS;
        const float* lnf = ka->in[22]; const float* wr = ka->in[23]; const float* br = ka->in[24];
        LAS float* xs = (LAS float*)(lds + RING_OFF);
        LAS float* wsl = (LAS float*)(lds + RING_OFF + 66560);
        LAS float* rst = (LAS float*)(lds + RING_OFF + 99328);
        LAS unsigned* lcnt = (LAS unsigned*)(lds + RING_OFF + 99328 + 256); LAS unsigned* lbase = lcnt + 32; LAS unsigned* ent_a = lcnt + 64; LAS float* ent_g = (LAS float*)(ent_a + 512);
        const int e_ = lane & 31, dh = lane >> 5, tok_s = tid >> 3, seg = tid & 7;
        for (int pb = bx * 64; pb < T; pb += G * 64) {
            if (tid < 32) lcnt[tid] = 0u;
            f32x16 macc[2]; float ssq = 0.f;
#pragma unroll
            for (int i = 0; i < 16; ++i) { macc[0][i] = 0.f; macc[1][i] = 0.f; }
            const int r32 = lane & 31, hh = lane >> 5;
            v4u xwA[4], xwB[4]; f32x4 wv[4];
            const int row = tid >> 1, c0 = (tid & 1) * 16;
            LAS float* lnl = (LAS float*)(lds + RING_OFF + 106496);
            *(LAS f32x4*)(lnl + 4 * tid) = *(const GAS f32x4*)(lnf + 4 * tid);
#define RT_LOAD(S_, sl_) do { const GAS v4u* src_ = (const GAS v4u*)(YB + (size_t)(pb + tok_s) * D + 256 * (sl_) + 32 * seg); \
                _Pragma("unroll") for (int q = 0; q < 4; ++q) xw##S_[q] = src_[q]; } while (0)
#define RT_LOADW(sl_) do { const GAS f32x4* wsrc_ = (const GAS f32x4*)(wr + (size_t)(256 * (sl_) + row) * 32 + c0); _Pragma("unroll") for (int q = 0; q < 4; ++q) wv[q] = wsrc_[q]; } while (0)
#define RT_XV(S_, q_) (((q_) & 1) ? (f32x4){__uint_as_float(xw##S_[(q_) >> 1].z << 16), __uint_as_float(xw##S_[(q_) >> 1].z & 0xffff0000u), __uint_as_float(xw##S_[(q_) >> 1].w << 16), __uint_as_float(xw##S_[(q_) >> 1].w & 0xffff0000u)} \
                                 : (f32x4){__uint_as_float(xw##S_[(q_) >> 1].x << 16), __uint_as_float(xw##S_[(q_) >> 1].x & 0xffff0000u), __uint_as_float(xw##S_[(q_) >> 1].y << 16), __uint_as_float(xw##S_[(q_) >> 1].y & 0xffff0000u)})
#define RT_BODY(S_, sl_) do { \
                { unsigned pk[8]; \
                  _Pragma("unroll") for (int q = 0; q < 8; ++q) { const f32x4 g = *(const LAS f32x4*)(lnl + 256 * (sl_) + 32 * seg + 4 * q); const f32x4 xq = RT_XV(S_, q); ssq += (xq.x * xq.x + xq.y * xq.y) + (xq.z * xq.z + xq.w * xq.w); \
                      pk[q] = (unsigned)pk4_fp8(sat8(16.0f * xq.x * g.x), sat8(16.0f * xq.y * g.y), sat8(16.0f * xq.z * g.z), sat8(16.0f * xq.w * g.w)); } \
                  GAS v4u* dst = (GAS v4u*)((unsigned char*)H2 + (size_t)(pb + tok_s) * D + 256 * (sl_) + 32 * seg); \
                  dst[0] = (v4u){pk[0], pk[1], pk[2], pk[3]}; dst[1] = (v4u){pk[4], pk[5], pk[6], pk[7]}; } \
                const float gsc = lnl[256 * (sl_) + row]; \
                __syncthreads();                                                \
                _Pragma("unroll") for (int q = 0; q < 8; ++q) *(LAS f32x4*)(xs + tok_s * 260 + 32 * seg + 4 * q) = RT_XV(S_, q); \
                _Pragma("unroll") for (int q = 0; q < 4; ++q) *(LAS f32x4*)(wsl + row * 32 + c0 + 4 * q) = wv[q] * gsc; \
                __syncthreads(); \
                if ((sl_) + 2 < 8) RT_LOAD(S_, (sl_) + 2); if ((sl_) + 1 < 8) RT_LOADW((sl_) + 1); __builtin_amdgcn_sched_barrier(0); \
                _Pragma("unroll") for (int uu = 0; uu < 4; ++uu) { const int u8 = 8 * (4 * wave + uu) + 4 * hh;        \
                    const f32x4 a0 = *(const LAS f32x4*)(xs + r32 * 260 + u8), a1 = *(const LAS f32x4*)(xs + (32 + r32) * 260 + u8); \
                    const LAS float* wp = wsl + u8 * 32 + r32; const float b0 = wp[0], b1 = wp[32], b2 = wp[64], b3 = wp[96]; \
                    macc[0] = __builtin_amdgcn_mfma_f32_32x32x2f32(a0.x, b0, macc[0], 0, 0, 0); macc[1] = __builtin_amdgcn_mfma_f32_32x32x2f32(a1.x, b0, macc[1], 0, 0, 0); \
                    macc[0] = __builtin_amdgcn_mfma_f32_32x32x2f32(a0.y, b1, macc[0], 0, 0, 0); macc[1] = __builtin_amdgcn_mfma_f32_32x32x2f32(a1.y, b1, macc[1], 0, 0, 0); \
                    macc[0] = __builtin_amdgcn_mfma_f32_32x32x2f32(a0.z, b2, macc[0], 0, 0, 0); macc[1] = __builtin_amdgcn_mfma_f32_32x32x2f32(a1.z, b2, macc[1], 0, 0, 0); \
                    macc[0] = __builtin_amdgcn_mfma_f32_32x32x2f32(a0.w, b3, macc[0], 0, 0, 0); macc[1] = __builtin_amdgcn_mfma_f32_32x32x2f32(a1.w, b3, macc[1], 0, 0, 0); if (uu & 1) __builtin_amdgcn_sched_barrier(0); } } while (0)
            RT_LOAD(A, 0); RT_LOAD(B, 1); RT_LOADW(0);
            __syncthreads();
#pragma unroll 1
            for (int sl = 0; sl < 8; sl += 2) { RT_BODY(A, sl); RT_BODY(B, sl + 1); }
#undef RT_BODY
#undef RT_XV
#undef RT_LOAD
#undef RT_LOADW
            ssq += __shfl_xor(ssq, 1); ssq += __shfl_xor(ssq, 2); ssq += __shfl_xor(ssq, 4);
            if (seg == 0) { const float rv = 1.0f / sqrtf(ssq * (1.f / D) + RMS_EPS); rst[tok_s] = rv; RSTD[pb + tok_s] = rv; }
            __syncthreads();
#pragma unroll
            for (int mt = 0; mt < 2; ++mt)
#pragma unroll
                for (int i = 0; i < 16; ++i) xs[(wave * 64 + 32 * mt + (i & 3) + 8 * (i >> 2) + 4 * hh) * 32 + r32] = macc[mt][i];
            __syncthreads();
#pragma unroll
            for (int q = 0; q < 4; ++q) { const int idx = tid + 512 * q; float sacc = 0.f;
#pragma unroll
                for (int w = 0; w < 8; ++w) sacc += xs[w * 2048 + idx];
                wsl[idx] = sacc; }
            __syncthreads();
            const float bias = br[e_];
            int nent = 0;
#pragma unroll
            for (int i = 0; i < 8; ++i) {
                const int t = pb + wave * 8 + i;
                const float lg = wsl[(wave * 8 + i) * 32 + e_] * rst[wave * 8 + i] + bias;
                const unsigned u = __float_as_uint(lg); const unsigned o = (u & 0x80000000u) ? ~u : (u | 0x80000000u);
                unsigned key = (o & ~31u) | (unsigned)(31 - e_);
                float val[4]; int sel[4];
#pragma unroll
                for (int k = 0; k < 4; ++k) { unsigned best = key;
#pragma unroll
                    for (int d = 1; d < 32; d <<= 1) { const unsigned ot = (unsigned)__shfl_xor((int)best, d); best = ot > best ? ot : best; }
                    key = key == best ? 0u : key;
                    sel[k] = 31 - (int)(best & 31u); const unsigned ob = best & ~31u; val[k] = __uint_as_float((ob & 0x80000000u) ? (ob & 0x7fffffffu) : ~ob); }
                const float w0 = 1.0f, w1 = __expf(val[1] - val[0]), w2 = __expf(val[2] - val[0]), w3 = __expf(val[3] - val[0]); const float inv = 1.0f / (w0 + w1 + w2 + w3);
                if (lane < 4) {
                    const int e = lane == 0 ? sel[0] : lane == 1 ? sel[1] : lane == 2 ? sel[2] : sel[3];
                    const float gt_ = (lane == 0 ? w0 : lane == 1 ? w1 : lane == 2 ? w2 : w3) * inv;
                    const unsigned lr = __hip_atomic_fetch_add(lcnt + e, 1u, __ATOMIC_RELAXED, __HIP_MEMORY_SCOPE_WORKGROUP);
                    const int ii = wave * 64 + nent + lane;
                    ent_a[ii] = (unsigned)(t * 4 + lane) | ((unsigned)e << 16) | (lr << 21); ent_g[ii] = gt_;
                }
                nent += 4;
            }
            __syncthreads();
            if (tid < 32) lbase[tid] = __hip_atomic_fetch_add(cnt_g + 64 * tid, lcnt[tid], RLX_AGENT);
            __syncthreads();
            for (int i = lane; i < nent; i += 64) { const unsigned a = ent_a[wave * 64 + i]; const int tk4 = (int)(a & 0xffffu), e = (int)((a >> 16) & 31u); const unsigned rank = lbase[e] + (a >> 21);
                tok_by_e[(size_t)e * T + rank] = tk4 >> 2; route_e[tk4] = e; route_rank[tk4] = (int)rank; route_gate[tk4] = ent_g[wave * 64 + i]; }
            __syncthreads();
        }
    }
    SEAM(10);
    if (IN(12)) { PH_PTRS;
        moe_tiles(cnt_g, lds, tid);
        const LAS int* texp = (const LAS int*)(lds + TEXP_OFF); const int nMt = *(const LAS int*)(lds + NMT_OFF);
        pg8::Gemm g{(const bf16*)H2, W1_T, nMt * 256, HID, D, D, D};
        pg8::GatherOrder<FF, D, 4, 2> S; S.init(nMt * 256, HID, G, bx); S.texp = texp; S.estride = (size_t)HID * D; S.ub = 0 - ((bx >> 3) & 3); S.ucount = 0;
        S.wsrc = &ka->in[27]; S.wsp = &ka->ws; S.wsoff = WS_W2;
        S.ldsb = lds;
        pg8::EpiSwiglu E{(unsigned char*)ACT, ka->in[26], texp, RSTD, (const LAS int*)(lds + TOKT_OFF)};
        pg8::gemm_phase<pg8::EpiSwiglu, pg8::GatherOrder<FF, D, 4, 2>, true, true, 1>(lds + RING_OFF, g, S, E);
        for (int it_ = gw + 8 * NGW; it_ < NE * I_2; it_ += NGW) { const int e_ = it_ / I_2; p0_tr8_item_h(ka->in[27] + (size_t)e_ * FF * D, FF, D, (unsigned char*)W2_T + (size_t)e_ * D * FF, it_ % I_2, lane, 512.0f); }
    }
    SEAM(12);
    if (IN(13)) { PH_PTRS;
        moe_tiles(cnt_g, lds, tid);
        const LAS int* texp = (const LAS int*)(lds + TEXP_OFF); const int nMt = *(const LAS int*)(lds + NMT_OFF);
        pg8::Gemm g{ACT, W2_T, nMt * 256, D, FF, FF, FF}; pg8::StaticOrder S; S.init(nMt * 256, D, G, bx); S.texp = texp; S.estride = (size_t)D * FF;
        pg8::EpiEo E{(unsigned char*)EO, ka->in[28], texp};
        pg8::gemm_phase<pg8::EpiEo, pg8::StaticOrder, true, true, 1>(lds + RING_OFF, g, S, E);
    }
    SEAM(13);
    if (IN(14)) { PH_PTRS;
        moe_tiles(cnt_g, lds, tid);
        const LAS int* pads = (const LAS int*)(lds + PADS_OFF);
        for (int t = gw; t < T; t += NGW) {
            int slot[4]; float gk[4];
#pragma unroll
            for (int k = 0; k < 4; ++k) { slot[k] = pads[route_e[t * 4 + k]] + route_rank[t * 4 + k]; gk[k] = route_gate[t * 4 + k]; }
            GAS f32x4* orow = (GAS f32x4*)(out + (size_t)t * D);
            typedef float f32x2c __attribute__((ext_vector_type(2)));
            v4u w[2][4]; f32x4 a[2][4];
#pragma unroll
            for (int j = 0; j < 2; ++j) { const int c16 = lane + 64 * j;
#pragma unroll
                for (int q = 0; q < 2; ++q) { const v4u xa = *((const GAS v4u*)(YB + (size_t)t * D) + 2 * c16 + q);
                    a[j][2 * q] = (f32x4){__uint_as_float(xa.x << 16), __uint_as_float(xa.x & 0xffff0000u), __uint_as_float(xa.y << 16), __uint_as_float(xa.y & 0xffff0000u)};
                    a[j][2 * q + 1] = (f32x4){__uint_as_float(xa.z << 16), __uint_as_float(xa.z & 0xffff0000u), __uint_as_float(xa.w << 16), __uint_as_float(xa.w & 0xffff0000u)}; }
#pragma unroll
                for (int k = 0; k < 4; ++k) w[j][k] = *((const GAS v4u*)((const unsigned char*)EO + (size_t)slot[k] * D) + c16); }
#pragma unroll
            for (int j = 0; j < 2; ++j) { const int c16 = lane + 64 * j;
#pragma unroll
                for (int k = 0; k < 4; ++k) { const float g = gk[k] * (1.0f / 32.0f);
#pragma unroll
                    for (int q = 0; q < 4; ++q) { const unsigned ww = q == 0 ? w[j][k].x : q == 1 ? w[j][k].y : q == 2 ? w[j][k].z : w[j][k].w;
                        const f32x2c lo = __builtin_amdgcn_cvt_pk_f32_fp8((int)ww, false), hi = __builtin_amdgcn_cvt_pk_f32_fp8((int)ww, true);
                        a[j][q].x += g * lo.x; a[j][q].y += g * lo.y; a[j][q].z += g * hi.x; a[j][q].w += g * hi.y; } }
#pragma unroll
                for (int q = 0; q < 4; ++q) orow[4 * c16 + q] = a[j][q]; }
        }
    }
#undef IN
#undef SEAM
}

extern "C" void kernel_launch(void* const* d_in, const int* in_sizes, int n_in, void* d_out, int out_size, void* d_ws, size_t ws_size, hipStream_t stream) {
    static int grid = 0;
    if (grid == 0) {
        if (n_in != 29 || out_size != T * D || ws_size < WS_END) { fprintf(stderr, "kernel_launch: unexpected shapes (n_in %d out %d ws %zu)\n", n_in, out_size, ws_size); grid = -1; return; }
        int dev = 0, cus = 0, per_cu = 0;
        if (hipGetDevice(&dev) != hipSuccess || hipDeviceGetAttribute(&cus, hipDeviceAttributeMultiprocessorCount, dev) != hipSuccess) { grid = -1; return; }
        if (hipFuncSetAttribute((const void*)fwd_kernel, hipFuncAttributeMaxDynamicSharedMemorySize, LDS_BYTES) != hipSuccess) { fprintf(stderr, "kernel_launch: hipFuncSetAttribute failed\n"); grid = -1; return; }
        if (hipOccupancyMaxActiveBlocksPerMultiprocessor(&per_cu, (const void*)fwd_kernel, NTHR, LDS_BYTES) != hipSuccess || per_cu < 1) fprintf(stderr, "kernel_launch: occupancy query reports %d\n", per_cu);
        (void)hipGetLastError();
        grid = cus;
    }
    if (grid < 0) return;
    (void)hipMemsetAsync((char*)d_ws + WS_CTL, 0, CTL_ZERO_BYTES, stream);
    Args a{};
    for (int i = 0; i < 29; ++i) a.in[i] = (const float*)d_in[i];
    a.out = (float*)d_out; a.ws = (unsigned char*)d_ws;
#ifndef N_LAUNCH_SPLIT
#define N_LAUNCH_SPLIT 0
#endif
#if N_LAUNCH_SPLIT
    for (int ph = 0; ph < NPHASE; ++ph) { a.ph_lo = ph; a.ph_hi = ph + 1; hipLaunchKernelGGL(fwd_kernel, dim3(grid), dim3(NTHR), LDS_BYTES, stream, a); }
#else
    a.ph_lo = 0; a.ph_hi = NPHASE; hipLaunchKernelGGL(fwd_kernel, dim3(grid), dim3(NTHR), LDS_BYTES, stream, a);
#endif
}
```

```cpp
#include <hip/hip_runtime.h>
#include <cstdio>
#include <cstdint>
#include <type_traits>
namespace pg8 {
#define PG8_LAS __attribute__((address_space(3)))
typedef unsigned short bf16_t;
typedef short bf16x8 __attribute__((ext_vector_type(8)));
typedef float f32x4 __attribute__((ext_vector_type(4)));
typedef unsigned u32x4 __attribute__((ext_vector_type(4)));
typedef int v4i_t __attribute__((ext_vector_type(4)));
constexpr int BM = 256, BK = 64, HALF = 128, HTB = HALF * BK * 2  , STAGE_BYTES = 8 * HTB, NXCD = 8, WGM = 8;

__host__ __device__ __forceinline__ int lds_byte(int r, int c) { const int st = (r >> 4) * 2 + (c >> 5), rr = r & 15, cc = c & 31, ob = rr * 64 + cc * 2; return st * 1024 + (ob ^ (((ob >> 9) & 1) << 5)); }
__host__ __device__ __forceinline__ void stage_rc(int b, int& R, int& C) { const int st = b / 1024, sb = b % 1024, swz = sb ^ (((sb >> 9) & 1) << 5); R = (st >> 1) * 16 + swz / 64; C = (st & 1) * 32 + (swz % 64) / 2; }
__host__ __device__ __forceinline__ int perm32(int rho) { const int n = rho >> 4, i = rho & 15; return 8 * (i >> 2) + 4 * n + (i & 3); }

struct Unit { int pm, pn, slot; };
struct Gemm { const bf16_t* A; const bf16_t* Bt; int M, N, K, lda, ldb; };

struct StaticOrder {
    static constexpr bool GATHER = false;
    int nM, nN, nwg, G, c; const PG8_LAS int* texp; size_t estride; const PG8_LAS int* arow;
    __host__ __device__ void init(int M, int N, int G_, int c_) { nM = M / BM; nN = N / BM; nwg = nM * nN; G = G_; c = c_; texp = nullptr; estride = 0; arow = nullptr; }
    __device__ __forceinline__ size_t aoff(const Unit& u, size_t tstepA) const { return arow ? (size_t)arow[u.pm] * (tstepA / BM) : (size_t)u.pm * tstepA; }
    __device__ __forceinline__ size_t boff(const Unit& u) const { return texp ? (size_t)texp[u.pm] * estride : (size_t)0; }
    __host__ __device__ bool next(int i, Unit& u) const {
        const long L = (long)i * G + c; if (L >= nwg) return false;
        int wgid = (int)L; { const int q = nwg / NXCD, r = nwg % NXCD, xcd = wgid % NXCD, off = wgid / NXCD; wgid = (xcd < r ? xcd * (q + 1) : r * (q + 1) + (xcd - r) * q) + off; }
        const int nig = WGM * nN, gid = wgid / nig, fm = gid * WGM, gsz = (nM - fm) < WGM ? (nM - fm) : WGM;
        u.pm = fm + ((wgid % nig) % gsz); u.pn = (wgid % nig) / gsz; u.slot = i % 3; return true;
    }
    __device__ __forceinline__ int tokrow(int, int) const { return 0; }
    __device__ __forceinline__ void gather_init(const Unit&) const {}
    __device__ __forceinline__ void a_ready(const Unit&) const {}
    __device__ __forceinline__ void done(const Unit&) const {}
};
struct PairOrder : StaticOrder {
    size_t a1, b1;
    __device__ __forceinline__ size_t aoff(const Unit& u, size_t tstepA) const { return (size_t)u.pm * tstepA + (u.slot ? a1 : (size_t)0); }
    __device__ __forceinline__ size_t boff(const Unit& u) const { return u.slot ? b1 : (size_t)0; }
    __host__ __device__ bool next(int i, Unit& u) const { if (!StaticOrder::next(i >> 1, u)) return false; u.slot = i & 1; return true; }
};
template <class E, class = void> struct epi_keep : std::false_type {};
template <class E> struct epi_keep<E, std::void_t<decltype(E::KEEP_ACC)>> : std::integral_constant<bool, E::KEEP_ACC> {};

typedef float f32x2_cv __attribute__((ext_vector_type(2))); typedef __bf16 bf16x2_cv __attribute__((ext_vector_type(2)));
__device__ __forceinline__ unsigned cvt_pk_bf16(float lo, float hi) { const f32x2_cv v = {lo, hi}; const bf16x2_cv b = __builtin_convertvector(v, bf16x2_cv); return __builtin_bit_cast(unsigned, b); }
typedef float f32x2 __attribute__((ext_vector_type(2)));
__device__ __forceinline__ f32x2 gelu_pk(f32x2 v) {
    const f32x2 av = __builtin_elementwise_abs(v), d = av * 0.2316418882f + 1.0f;
    f32x2 t; t.x = __builtin_amdgcn_rcpf(d.x); t.y = __builtin_amdgcn_rcpf(d.y);
    f32x2 q = t * 0.5307027145f + (-0.7265760135f); q = q * t + 0.7107068705f; q = q * t + (-0.142248368f); q = q * t + 0.127414796f; q = q * t;
    const f32x2 s = (v * v) * (-0.72134752044f);
    f32x2 e; e.x = __builtin_amdgcn_exp2f(s.x); e.y = __builtin_amdgcn_exp2f(s.y);
    const f32x2 m = v * (q * e), r = v - m;
    f32x2 o; o.x = v.x < 0.f ? m.x : r.x; o.y = v.y < 0.f ? m.y : r.y; return o;
}

template <int ACT  > struct EpiBf16 {
    static constexpr bool PERM = true, AFTER_DRAIN = false; static_assert(ACT == 0 || ACT == 1, "EpiBf16: ACT is 0 (none) or 1 (gelu_pk)");
    bf16_t* O; int ldc; const float* bias; int split_cols; size_t split_stride; float scale0;
    __device__ __forceinline__ void operator()(const f32x4 (&acc)[2][2][4][2], const Unit& u, int wr, int wc, int fr, int fq) const {
        const int row0 = u.pm * BM + wr * 64 + fr; int colt = u.pn * BM; bf16_t* base = O;
        float sc = 1.f; if (split_cols) { const int t = colt / split_cols; base += (size_t)t * split_stride; colt -= t * split_cols; if (t == 0) sc = scale0; }
        const int col0 = colt + wc * 32 + 8 * fq, bcol0 = u.pn * BM + wc * 32 + 8 * fq;
        f32x4 bv[2][2];
#pragma unroll
        for (int bj = 0; bj < 2; ++bj)
#pragma unroll
            for (int n = 0; n < 2; ++n) bv[bj][n] = bias ? *(const f32x4*)(bias + bcol0 + bj * HALF + 4 * n) : (f32x4){0.f, 0.f, 0.f, 0.f};
#pragma unroll
        for (int ai = 0; ai < 2; ++ai)
#pragma unroll
            for (int m = 0; m < 4; ++m) { bf16_t* rowp = base + (size_t)(row0 + ai * HALF + m * 16) * ldc + col0;
#pragma unroll
                for (int bj = 0; bj < 2; ++bj) { f32x4 v0 = acc[ai][bj][m][0] + bv[bj][0], v1 = acc[ai][bj][m][1] + bv[bj][1];
                    if (ACT == 1) { f32x2 a = gelu_pk((f32x2){v0[0], v0[1]}), b = gelu_pk((f32x2){v0[2], v0[3]}), c = gelu_pk((f32x2){v1[0], v1[1]}), d = gelu_pk((f32x2){v1[2], v1[3]});
                        v0 = (f32x4){a.x, a.y, b.x, b.y}; v1 = (f32x4){c.x, c.y, d.x, d.y}; }
                    v0 = v0 * sc; v1 = v1 * sc; u32x4 w; w.x = cvt_pk_bf16(v0[0], v0[1]); w.y = cvt_pk_bf16(v0[2], v0[3]); w.z = cvt_pk_bf16(v1[0], v1[1]); w.w = cvt_pk_bf16(v1[2], v1[3]);
                    *(u32x4*)(rowp + bj * HALF) = w; } }
    }
};

template <class Epi, class Sched, bool ALIGN_EPI = false, bool SP2 = false, int ES = 2  >
__device__ __forceinline__ void gemm_phase(PG8_LAS unsigned char* lds, const Gemm g, const Sched& S, const Epi& E) {
    const int tid = threadIdx.x, wid = __builtin_amdgcn_readfirstlane(tid >> 6), lane = tid & 63, wr = wid >> 2, wc = wid & 3, fr = lane & 15, fq = lane >> 4;
    const int K = g.K, nt = K * ES / (BK * 2);
    unsigned voffA[2], voffB[2];
#pragma unroll
    for (int i = 0; i < 2; ++i) { int R, C; stage_rc(tid * 16 + i * 8192, R, C); const int Rb = Epi::PERM ? ((R & ~31) + perm32(R & 31)) : R;
        voffA[i] = (unsigned)(R * g.lda * ES + C * 2); voffB[i] = (unsigned)(Rb * g.ldb * ES + C * 2); }
    const size_t kstep = (size_t)(BK * 2);
    constexpr bool GATHER = Sched::GATHER;
    static_assert(!GATHER || SP2, "the gathered-A path is written for the SP2 loop");
    const size_t hstepA = GATHER ? (size_t)0 : (size_t)HALF * g.lda * ES, hstepB = (size_t)HALF * g.ldb * ES;
    unsigned gc[2][2];
#pragma unroll
    for (int i = 0; i < 2; ++i) { gc[0][i] = gc[1][i] = 0u; }
#define PG8_GLOAD(dst, slot_) do { _Pragma("unroll") for (int i_ = 0; i_ < 2; ++i_) { int R_, C_; stage_rc(tid * 16 + i_ * 8192, R_, C_); _Pragma("unroll") for (int h_ = 0; h_ < 2; ++h_) \
        dst[h_][i_] = (unsigned)S.tokrow((slot_), h_ * HALF + R_) * (unsigned)(g.lda * ES) + (unsigned)(C_ * 2); } } while (0)
#define PG8_VAC(h, i) (GATHER ? gc[h][i] : voffA[i])
#define PG8_VAX(h, i) (GATHER ? gc[h][i] : voffA[i])
#define PG8_STAGE2(bufoff, gbase, v0, v1) do { \
        __builtin_amdgcn_global_load_lds((const unsigned*)((const char*)(gbase) + (v0)), (PG8_LAS unsigned*)(lds + (bufoff) + ldsw), 16, 0, 0); \
        __builtin_amdgcn_global_load_lds((const unsigned*)((const char*)(gbase) + (v1)), (PG8_LAS unsigned*)(lds + (bufoff) + ldsw + 8192), 16, 0, 0); } while (0)
    const size_t tstepA = 2 * hstepA, tstepB = 2 * hstepB;
    const unsigned ldsw = (unsigned)wid * 1024u;
    const int aoff = lds_byte(wr * 64 + fr, fq * 8), boff = lds_byte(wc * 32 + fr, fq * 8);
#define PG8_SA(b, h) (((b) * 2 + (h)) * HTB)
#define PG8_SB(b, h) ((4 + (b) * 2 + (h)) * HTB)
#define PG8_STAGE(bufoff, gbase, voff) do { _Pragma("unroll") for (int _i = 0; _i < 2; ++_i) \
        __builtin_amdgcn_global_load_lds((const unsigned*)((const char*)(gbase) + (voff)[_i]), (PG8_LAS unsigned*)(lds + (bufoff) + ldsw + _i * 8192), 16, 0, 0); } while (0)
#define PG8_RD(off) (*(const PG8_LAS v4i_t*)(lds + (off)))
#define PG8_LDA(dst, b, h) do { if constexpr (ES == 2) { _Pragma("unroll") for (int m = 0; m < 4; ++m) _Pragma("unroll") for (int k = 0; k < 2; ++k) dst[m][k] = __builtin_bit_cast(bf16x8, PG8_RD(PG8_SA(b, h) + aoff + m * 2048 + k * 1024)); } \
    else { _Pragma("unroll") for (int m = 0; m < 4; ++m) dst[m] = __builtin_shufflevector(PG8_RD(PG8_SA(b, h) + aoff + m * 2048), PG8_RD(PG8_SA(b, h) + aoff + m * 2048 + 1024), 0, 1, 2, 3, 4, 5, 6, 7); } } while (0)
#define PG8_LDB(dst, b, h) do { if constexpr (ES == 2) { _Pragma("unroll") for (int n = 0; n < 2; ++n) _Pragma("unroll") for (int k = 0; k < 2; ++k) dst[n][k] = __builtin_bit_cast(bf16x8, PG8_RD(PG8_SB(b, h) + boff + n * 2048 + k * 1024)); } \
    else { _Pragma("unroll") for (int n = 0; n < 2; ++n) dst[n] = __builtin_shufflevector(PG8_RD(PG8_SB(b, h) + boff + n * 2048), PG8_RD(PG8_SB(b, h) + boff + n * 2048 + 1024), 0, 1, 2, 3, 4, 5, 6, 7); } } while (0)
#define PG8_MMA(ai, bj, At, Bt) do { __builtin_amdgcn_s_setprio(1); if constexpr (ES == 2) { _Pragma("unroll") for (int m = 0; m < 4; ++m) _Pragma("unroll") for (int n = 0; n < 2; ++n) _Pragma("unroll") for (int k = 0; k < 2; ++k) \
        acc[ai][bj][m][n] = __builtin_amdgcn_mfma_f32_16x16x32_bf16(Bt[n][k], At[m][k], acc[ai][bj][m][n], 0, 0, 0); } else { _Pragma("unroll") for (int m = 0; m < 4; ++m) _Pragma("unroll") for (int n = 0; n < 2; ++n) \
        { if (m == 0 && n == 0) asm volatile("s_nop 4\n\tv_mfma_scale_f32_16x16x128_f8f6f4 %0, %1, %2, %0, %3, %3 op_sel_hi:[0,0,0]" : "+v"(acc[ai][bj][m][n]) : "v"(Bt[n]), "v"(At[m]), "v"(sc8)); \
        else asm volatile("v_mfma_scale_f32_16x16x128_f8f6f4 %0, %1, %2, %0, %3, %3 op_sel_hi:[0,0,0]" : "+v"(acc[ai][bj][m][n]) : "v"(Bt[n]), "v"(At[m]), "v"(sc8)); } } __builtin_amdgcn_s_setprio(0); } while (0)
#define PG8_WAIT_V(n) asm volatile("s_waitcnt vmcnt(" #n ")" ::: "memory")
#define PG8_WAIT_L(n) asm volatile("s_waitcnt lgkmcnt(" #n ")" ::: "memory")
#define PG8_BAR __builtin_amdgcn_s_barrier()
#define PG8_SCHED __builtin_amdgcn_sched_barrier(0)
    Unit cur, nxt; int ui = 0;
    if (!S.next(0, cur)) return;
    const int sc8 = 0x7f7f7f7f;
    f32x4 acc[2][2][4][2];
#pragma unroll
    for (int a = 0; a < 2; ++a)
#pragma unroll
        for (int b = 0; b < 2; ++b)
#pragma unroll
            for (int m = 0; m < 4; ++m)
#pragma unroll
                for (int n = 0; n < 2; ++n) acc[a][b][m][n] = (f32x4){0.f, 0.f, 0.f, 0.f};
    typedef int v8i_t __attribute__((ext_vector_type(8)));
    typename std::conditional<ES == 2, bf16x8[4][2], v8i_t[4]>::type At; typename std::conditional<ES == 2, bf16x8[2][2], v8i_t[2]>::type B0, B1;
    if constexpr (ES == 1) {
        asm volatile("s_nop 1" : "+v"(acc[0][0][0][0]), "+v"(acc[0][0][0][1]), "+v"(acc[0][0][1][0]), "+v"(acc[0][0][1][1]), "+v"(acc[0][0][2][0]), "+v"(acc[0][0][2][1]), "+v"(acc[0][0][3][0]), "+v"(acc[0][0][3][1]),
                                   "+v"(acc[0][1][0][0]), "+v"(acc[0][1][0][1]), "+v"(acc[0][1][1][0]), "+v"(acc[0][1][1][1]), "+v"(acc[0][1][2][0]), "+v"(acc[0][1][2][1]), "+v"(acc[0][1][3][0]), "+v"(acc[0][1][3][1]));
        asm volatile("s_nop 1" : "+v"(acc[1][0][0][0]), "+v"(acc[1][0][0][1]), "+v"(acc[1][0][1][0]), "+v"(acc[1][0][1][1]), "+v"(acc[1][0][2][0]), "+v"(acc[1][0][2][1]), "+v"(acc[1][0][3][0]), "+v"(acc[1][0][3][1]),
                                   "+v"(acc[1][1][0][0]), "+v"(acc[1][1][0][1]), "+v"(acc[1][1][1][0]), "+v"(acc[1][1][1][1]), "+v"(acc[1][1][2][0]), "+v"(acc[1][1][2][1]), "+v"(acc[1][1][3][0]), "+v"(acc[1][1][3][1]));
    }
    const char* cA = (const char*)g.A + (GATHER ? (size_t)0 : S.aoff(cur, tstepA)); const char* cB = (const char*)g.Bt + (size_t)cur.pn * tstepB + S.boff(cur);
    S.a_ready(cur);
    if constexpr (GATHER) { S.gather_init(cur); PG8_GLOAD(gc, cur.slot); }
    if constexpr (SP2) {
        PG8_STAGE(PG8_SB(0, 0), cB, voffB); PG8_STAGE(PG8_SB(0, 1), cB + hstepB, voffB); PG8_STAGE2(PG8_SA(0, 0), cA, PG8_VAC(0, 0), PG8_VAC(0, 1)); PG8_STAGE2(PG8_SA(0, 1), cA + hstepA, PG8_VAC(1, 0), PG8_VAC(1, 1));
        if (wr == 1) PG8_BAR;
        PG8_WAIT_V(2); PG8_BAR;
        PG8_STAGE(PG8_SB(1, 0), cB + kstep, voffB); PG8_STAGE2(PG8_SA(1, 0), cA + kstep, PG8_VAC(0, 0), PG8_VAC(0, 1)); PG8_STAGE(PG8_SB(1, 1), cB + hstepB + kstep, voffB);
        PG8_WAIT_V(6); PG8_BAR;
    } else {
        PG8_STAGE(PG8_SB(0, 0), cB, voffB); PG8_STAGE(PG8_SA(0, 0), cA, voffA); PG8_STAGE(PG8_SB(0, 1), cB + hstepB, voffB); PG8_STAGE(PG8_SA(0, 1), cA + hstepA, voffA);
        if (wr == 1) PG8_BAR;
        PG8_WAIT_V(4); PG8_BAR;
        PG8_STAGE(PG8_SB(1, 0), cB + kstep, voffB); PG8_STAGE(PG8_SA(1, 0), cA + kstep, voffA); PG8_STAGE(PG8_SB(1, 1), cB + hstepB + kstep, voffB);
        PG8_WAIT_V(6); PG8_BAR;
    }
    for (;;) {
        const bool has_next = S.next(ui + 1, nxt);
        const char* nA = (has_next && !GATHER) ? (const char*)g.A + S.aoff(nxt, tstepA) : cA; const char* nB = has_next ? (const char*)g.Bt + (size_t)nxt.pn * tstepB + S.boff(nxt) : cB;
        for (int t = 0; t < nt; t += 2) {
            const bool last = (t == nt - 2);
            const char* a1 = cA + (size_t)(t + 1) * kstep;
            const char* a2 = last ? nA : cA + (size_t)(t + 2) * kstep; const char* b2 = last ? nB : cB + (size_t)(t + 2) * kstep;
            const char* a3 = a2 + kstep; const char* b3 = b2 + kstep;
            if (last && has_next) S.a_ready(nxt);
            if constexpr (SP2) {
            PG8_LDB(B0, 0, 0); PG8_LDB(B1, 0, 1); PG8_SCHED; PG8_LDA(At, 0, 0); PG8_STAGE2(PG8_SA(1, 1), a1 + hstepA, PG8_VAC(1, 0), PG8_VAC(1, 1)); if constexpr (GATHER) { if (last && has_next) PG8_GLOAD(gc, nxt.slot); }
            PG8_WAIT_V(8); PG8_WAIT_L(0); PG8_BAR; PG8_MMA(0, 0, At, B0); PG8_MMA(0, 1, At, B1); PG8_BAR; PG8_SCHED;
            PG8_LDA(At, 0, 1); PG8_STAGE(PG8_SB(0, 0), b2, voffB); PG8_STAGE(PG8_SB(0, 1), b2 + hstepB, voffB); PG8_STAGE2(PG8_SA(0, 0), a2, PG8_VAX(0, 0), PG8_VAX(0, 1));
            PG8_WAIT_V(8); PG8_WAIT_L(0); PG8_BAR; PG8_MMA(1, 0, At, B0); PG8_MMA(1, 1, At, B1); PG8_BAR; PG8_SCHED;
            PG8_LDB(B0, 1, 0); PG8_LDB(B1, 1, 1); PG8_SCHED; PG8_LDA(At, 1, 0); PG8_STAGE2(PG8_SA(0, 1), a2 + hstepA, PG8_VAX(1, 0), PG8_VAX(1, 1));
            PG8_WAIT_V(8); PG8_WAIT_L(0); PG8_BAR; PG8_MMA(0, 0, At, B0); PG8_MMA(0, 1, At, B1); PG8_BAR; PG8_SCHED;
            PG8_LDA(At, 1, 1); PG8_STAGE(PG8_SB(1, 0), b3, voffB); PG8_STAGE(PG8_SB(1, 1), b3 + hstepB, voffB); PG8_STAGE2(PG8_SA(1, 0), a3, PG8_VAX(0, 0), PG8_VAX(0, 1));
            PG8_WAIT_V(8); PG8_WAIT_L(0); PG8_BAR; PG8_MMA(1, 0, At, B0); PG8_MMA(1, 1, At, B1); PG8_BAR; PG8_SCHED;
            } else {
            PG8_LDB(B0, 0, 0); PG8_SCHED; PG8_LDA(At, 0, 0); PG8_STAGE(PG8_SA(1, 1), a1 + hstepA, voffA);
            PG8_WAIT_L(8); PG8_BAR; PG8_WAIT_L(0); PG8_MMA(0, 0, At, B0); PG8_BAR; PG8_SCHED;
            PG8_LDB(B1, 0, 1); PG8_STAGE(PG8_SB(0, 0), b2, voffB);
            PG8_BAR; PG8_WAIT_L(0); PG8_MMA(0, 1, At, B1); PG8_BAR;
            PG8_LDA(At, 0, 1); PG8_STAGE(PG8_SA(0, 0), a2, voffA);
            PG8_BAR; PG8_WAIT_L(0); PG8_MMA(1, 0, At, B0); PG8_BAR; PG8_SCHED;
            PG8_STAGE(PG8_SB(0, 1), b2 + hstepB, voffB);
            PG8_WAIT_V(6); PG8_BAR; PG8_MMA(1, 1, At, B1); PG8_BAR;
            PG8_LDB(B0, 1, 0); PG8_SCHED; PG8_LDA(At, 1, 0); PG8_STAGE(PG8_SA(0, 1), a2 + hstepA, voffA);
            PG8_WAIT_L(8); PG8_BAR; PG8_WAIT_L(0); PG8_MMA(0, 0, At, B0); PG8_BAR; PG8_SCHED;
            PG8_LDB(B1, 1, 1); PG8_STAGE(PG8_SB(1, 0), b3, voffB);
            PG8_BAR; PG8_WAIT_L(0); PG8_MMA(0, 1, At, B1); PG8_BAR;
            PG8_LDA(At, 1, 1); PG8_STAGE(PG8_SA(1, 0), a3, voffA);
            PG8_BAR; PG8_WAIT_L(0); PG8_MMA(1, 0, At, B0); PG8_BAR; PG8_SCHED;
            PG8_STAGE(PG8_SB(1, 1), b3 + hstepB, voffB);
            PG8_WAIT_V(6); PG8_BAR; PG8_MMA(1, 1, At, B1); PG8_BAR;
            }
        }
        if constexpr (ALIGN_EPI) { if (wr == 0) PG8_BAR; }
        if constexpr (ES == 1) {
            asm volatile("s_nop 15\n\ts_nop 15" : "+v"(acc[1][0][0][0]), "+v"(acc[1][0][0][1]), "+v"(acc[1][0][1][0]), "+v"(acc[1][0][1][1]), "+v"(acc[1][0][2][0]), "+v"(acc[1][0][2][1]), "+v"(acc[1][0][3][0]), "+v"(acc[1][0][3][1]),
                                                       "+v"(acc[1][1][0][0]), "+v"(acc[1][1][0][1]), "+v"(acc[1][1][1][0]), "+v"(acc[1][1][1][1]), "+v"(acc[1][1][2][0]), "+v"(acc[1][1][2][1]), "+v"(acc[1][1][3][0]), "+v"(acc[1][1][3][1]));
            asm volatile("" : "+v"(acc[0][0][0][0]), "+v"(acc[0][0][0][1]), "+v"(acc[0][0][1][0]), "+v"(acc[0][0][1][1]), "+v"(acc[0][0][2][0]), "+v"(acc[0][0][2][1]), "+v"(acc[0][0][3][0]), "+v"(acc[0][0][3][1]),
                                "+v"(acc[0][1][0][0]), "+v"(acc[0][1][0][1]), "+v"(acc[0][1][1][0]), "+v"(acc[0][1][1][1]), "+v"(acc[0][1][2][0]), "+v"(acc[0][1][2][1]), "+v"(acc[0][1][3][0]), "+v"(acc[0][1][3][1]));
        }
        bool keep_acc = false;
        if constexpr (!Epi::AFTER_DRAIN) { if constexpr (epi_keep<Epi>::value) { if (cur.slot == 0) { E.mid(acc, cur, wr, wc, fr, fq); keep_acc = true; } else E(acc, cur, wr, wc, fr, fq); } else E(acc, cur, wr, wc, fr, fq); S.done(cur); }
        if (!has_next) break;
        if (!keep_acc) {
#pragma unroll
        for (int a = 0; a < 2; ++a)
#pragma unroll
            for (int b = 0; b < 2; ++b)
#pragma unroll
                for (int m = 0; m < 4; ++m)
#pragma unroll
                    for (int n = 0; n < 2; ++n) acc[a][b][m][n] = (f32x4){0.f, 0.f, 0.f, 0.f};
        }
        if constexpr (ES == 1) {
            asm volatile("s_nop 1" : "+v"(acc[0][0][0][0]), "+v"(acc[0][0][0][1]), "+v"(acc[0][0][1][0]), "+v"(acc[0][0][1][1]), "+v"(acc[0][0][2][0]), "+v"(acc[0][0][2][1]), "+v"(acc[0][0][3][0]), "+v"(acc[0][0][3][1]),
                                       "+v"(acc[0][1][0][0]), "+v"(acc[0][1][0][1]), "+v"(acc[0][1][1][0]), "+v"(acc[0][1][1][1]), "+v"(acc[0][1][2][0]), "+v"(acc[0][1][2][1]), "+v"(acc[0][1][3][0]), "+v"(acc[0][1][3][1]));
            asm volatile("s_nop 1" : "+v"(acc[1][0][0][0]), "+v"(acc[1][0][0][1]), "+v"(acc[1][0][1][0]), "+v"(acc[1][0][1][1]), "+v"(acc[1][0][2][0]), "+v"(acc[1][0][2][1]), "+v"(acc[1][0][3][0]), "+v"(acc[1][0][3][1]),
                                       "+v"(acc[1][1][0][0]), "+v"(acc[1][1][0][1]), "+v"(acc[1][1][1][0]), "+v"(acc[1][1][1][1]), "+v"(acc[1][1][2][0]), "+v"(acc[1][1][2][1]), "+v"(acc[1][1][3][0]), "+v"(acc[1][1][3][1]));
        }
        cur = nxt; cA = nA; cB = nB; ++ui;

        if constexpr (ALIGN_EPI) { if (wr == 1) PG8_BAR; }
    }
    PG8_WAIT_V(0);
    if constexpr (!ALIGN_EPI) { if (wr == 0) PG8_BAR; }
    PG8_BAR;
    if constexpr (Epi::AFTER_DRAIN) { E.fused(acc, cur, wr, wc, fr, fq, lds, wid, lane); S.done(cur); }
#undef PG8_SA
#undef PG8_SB
#undef PG8_STAGE
#undef PG8_STAGE2
#undef PG8_GLOAD
#undef PG8_VAC
#undef PG8_VAX
#undef PG8_LDA
#undef PG8_LDB
#undef PG8_MMA
#undef PG8_RD
#undef PG8_WAIT_V
#undef PG8_WAIT_L
#undef PG8_BAR
#undef PG8_SCHED
}
}

#define GAS __attribute__((address_space(1)))
#define LAS __attribute__((address_space(3)))
#define DEV __device__ __forceinline__
typedef unsigned short bf16;
typedef unsigned v4u __attribute__((ext_vector_type(4)));
typedef unsigned v2u __attribute__((ext_vector_type(2)));
typedef float f32x4 __attribute__((ext_vector_type(4)));
typedef GAS unsigned gu32;
#define RLX_AGENT __ATOMIC_RELAXED, __HIP_MEMORY_SCOPE_AGENT
#define LDS_WAIT() asm volatile("s_waitcnt lgkmcnt(0)" ::: "memory")
#define VM_WAIT() asm volatile("s_waitcnt vmcnt(0)" ::: "memory")

constexpr int NB = 4, SEQ = 4096, T = NB * SEQ, D = 2048;
constexpr int NH = 8, DK = 64, DV = 128, AW = 1024, LW = 1024;
constexpr int P5P = 5120;
constexpr int INC = 9216;
constexpr int C_Q = 0, C_K = 1024, C_V = 2048, C_XL = 3072, C_GL = 4096, C_GT = 5120;
constexpr int NE = 32, TOPK = 4, HID = 4096, FF = 2048;
constexpr int MAXTILES = 288, PMAX = MAXTILES * 256;
constexpr float RMS_EPS = 1e-6f;
constexpr int NWAVES = 8, NTHR = 512;

constexpr size_t MiB = (size_t)1 << 20;
constexpr size_t WS_CTL = 0, CTL_ZERO_BYTES = 1 * MiB;
constexpr size_t WS_WIN = 2 * MiB, WS_WA = 38 * MiB, WS_WB = 42 * MiB, WS_WOUT = 46 * MiB;
constexpr size_t WS_ROUTE = 54 * MiB;
constexpr size_t WS_WL = 57 * MiB;
constexpr size_t WS_W1 = 64 * MiB, WS_W2 = 576 * MiB;
constexpr size_t WS_H = 832 * MiB, WS_PROJ = 896 * MiB, WS_Q = 1184 * MiB, WS_K = 1216 * MiB, WS_OAB = 1248 * MiB;
constexpr size_t WS_LA = 1312 * MiB, WS_LU = 1376 * MiB, WS_YA = 1440 * MiB, WS_YB = 1504 * MiB, WS_MIX = 1568 * MiB, WS_H2 = 1632 * MiB;
constexpr size_t WS_XG = 1696 * MiB, WS_ACT = 1984 * MiB, WS_EO = 2272 * MiB;
constexpr size_t WS_XGS = 2560 * MiB  , WS_RSS = 3584 * MiB  , WS_END = 3588 * MiB;
constexpr int CW_TMO = 0, CW_CODE = 1, CW_CNT = 8192  , CW_BAR = 4096;

constexpr int RING_OFF = 0, RING_BYTES = 131072;
constexpr int LDSCTL_OFF = RING_BYTES;
constexpr int MISC_OFF = LDSCTL_OFF;
constexpr int TEXP_OFF = LDSCTL_OFF + 256;
constexpr int PADS_OFF = TEXP_OFF + 1280;
constexpr int CNTL_OFF = PADS_OFF + 256;
constexpr int NMT_OFF = CNTL_OFF + 256;
constexpr int AROW_OFF = NMT_OFF + 64;
constexpr int TOKT_OFF = AROW_OFF + 1280;
constexpr int LDS_BYTES = 147456;
static_assert(TOKT_OFF + 3072 <= LDS_BYTES, "LDS map");

DEV float bf2f(unsigned v) { return __uint_as_float(v << 16); }
DEV unsigned f2bf(float f) { unsigned u = __builtin_bit_cast(unsigned, f); return (u + 0x7fffu + ((u >> 16) & 1u)) >> 16; }
DEV unsigned pk2(float lo, float hi) { return f2bf(lo) | (f2bf(hi) << 16); }
DEV float wave_sum(float v) {
#pragma unroll
    for (int o = 1; o < 64; o <<= 1) v += __shfl_xor(v, o);
    return v;
}
DEV float wave_max(float v) {
#pragma unroll
    for (int o = 1; o < 64; o <<= 1) v = fmaxf(v, __shfl_xor(v, o));
    return v;
}
DEV float sigmoidf_(float x) { return __builtin_amdgcn_rcpf(1.0f + __expf(-x)); }
DEV float gelu_tanh(float x) { const float u = 0.7978845608028654f * (x + 0.044715f * x * x * x); return 0.5f * x * (1.0f + tanhf(u)); }

DEV int t5_bucket(int rel) {
    const int ret = rel > 0 ? 16 : 0; const int n = rel < 0 ? -rel : rel;
    int v;
    if (n < 8) v = n;
    else if (n >= 128) v = 15;
    else { const int l2 = 31 - __builtin_clz((unsigned)(n * n)); int lg = 8 + (l2 - 6); v = lg < 15 ? lg : 15; }
    return ret + v;
}

#define XB_TMO      128
#define XB_XCNT(j)  (256  + 64 * (j))
#define XB_XSUB(j)  (1280 + 64 * (j))
#define XB_XGEN(j)  (2304 + 64 * (j))
#define XB_TOP      3328
#define XB_TOPGEN   3392
#define XCD_BAR_WORDS 3456
#define XB_SPIN_CAP (1u << 18)
DEV unsigned xb_ld(unsigned* p)              { return __hip_atomic_load(p, __ATOMIC_RELAXED, __HIP_MEMORY_SCOPE_AGENT); }
DEV unsigned xb_add(unsigned* p, unsigned v) { return __hip_atomic_fetch_add(p, v, __ATOMIC_RELAXED, __HIP_MEMORY_SCOPE_AGENT); }
DEV unsigned xb_xcc_id() { return (unsigned)__builtin_amdgcn_s_getreg((3 << 11) | 20) & 0xFu; }
#define XB_SPIN(cond, bar) do { unsigned _sp = 0; while (cond) { __builtin_amdgcn_s_sleep(1); \
    if ((++_sp & 255u) == 0u) { if (xb_ld(&(bar)[XB_TMO])) break; if (_sp > XB_SPIN_CAP) { atomicAdd(&(bar)[XB_TMO], 1u); break; } } } } while (0)
struct XcdBarrier { unsigned* bar; unsigned x; volatile LAS unsigned* st; };
DEV XcdBarrier xcd_barrier_post(unsigned* bar, volatile LAS unsigned* st) {
    XcdBarrier b; b.bar = bar; b.x = xb_xcc_id(); b.st = st;
    if (threadIdx.x == 0) (void)xb_add(&bar[XB_XCNT(b.x)], 1u);
    return b;
}
DEV void xcd_barrier_complete(unsigned* bar, unsigned x, unsigned& nloc, unsigned& nx) {
    const unsigned G = gridDim.x * gridDim.y * gridDim.z;
    unsigned sum, cnt, mine, sp = 0u;
    for (;;) {
        sum = 0u; cnt = 0u; mine = 0u;
#pragma unroll
        for (unsigned j = 0; j < 16; ++j) { const unsigned c = xb_ld(&bar[XB_XCNT(j)]); sum += c; cnt += (c > 0u) ? 1u : 0u; mine = (j == x) ? c : mine; }
        if (sum == G) break;
        __builtin_amdgcn_s_sleep(1);
        if ((++sp & 255u) == 0u) { if (xb_ld(&bar[XB_TMO])) break; if (sp > XB_SPIN_CAP) { atomicAdd(&bar[XB_TMO], 1u); break; } }
    }
    nloc = mine > 0u ? mine : 1u; nx = cnt > 0u ? cnt : 1u;
}
DEV void xcd_barrier(const XcdBarrier& b) {
    asm volatile("s_waitcnt vmcnt(0)" ::: "memory");
    __syncthreads();
    if (threadIdx.x == 0) {
        unsigned* bar = b.bar;
        __builtin_amdgcn_s_waitcnt(0);
        unsigned nloc = b.st[0], nx = b.st[1];
        if (nloc == 0u) { xcd_barrier_complete(bar, b.x, nloc, nx); b.st[0] = nloc; b.st[1] = nx; }
        const unsigned old = xb_add(&bar[XB_XSUB(b.x)], 1u);
        const unsigned gen = old / nloc;
        if (old + 1u == (gen + 1u) * nloc) {
            __builtin_amdgcn_fence(__ATOMIC_RELEASE, "agent");
            asm volatile("s_waitcnt vmcnt(0)" ::: "memory");
            const unsigned og = xb_add(&bar[XB_TOP], 1u);
            const unsigned tg = og / nx;
            if (og + 1u == (tg + 1u) * nx) xb_add(&bar[XB_TOPGEN], 1u);
            else XB_SPIN(xb_ld(&bar[XB_TOPGEN]) == tg, bar);
            __builtin_amdgcn_fence(__ATOMIC_ACQUIRE, "agent");
            xb_add(&bar[XB_XGEN(b.x)], 1u);
            asm volatile("s_waitcnt vmcnt(0)" ::: "memory");
        } else {
            XB_SPIN(xb_ld(&bar[XB_XGEN(b.x)]) == gen, bar);
            __builtin_amdgcn_fence(__ATOMIC_ACQUIRE, "agent");
            asm volatile("s_waitcnt vmcnt(0)" ::: "memory");
        }
    }
    __syncthreads();
}

namespace pg8 {

struct EpiProj {
    static constexpr bool PERM = true, AFTER_DRAIN = false;
    bf16_t* P5; bf16_t* G; const float* qg; const float* kg; const float* bgate; int pn_off; float asc;
    static __device__ __forceinline__ float gelu_t(float x) { const float u = 1.5957691216057308f * (x + 0.044715f * x * x * x); return x * __builtin_amdgcn_rcpf(1.0f + __expf(-u)); }
    static __device__ __forceinline__ float sigm(float x) { return __builtin_amdgcn_rcpf(1.0f + __expf(-x)); }
    static __device__ __forceinline__ unsigned q8(float z) { return (unsigned)fmaxf(sigm(z) * 255.0f + 0.5f, 1.0f); }
    __device__ __forceinline__ void operator()(const f32x4 (&acc_)[2][2][4][2], const Unit& u, int wr, int wc, int fr, int fq) const {
        const int pn = u.pn + pn_off, row0 = u.pm * BM + wr * 64 + fr;
        f32x4 acc[2][2][4][2];
#pragma unroll
        for (int a = 0; a < 2; ++a)
#pragma unroll
            for (int b = 0; b < 2; ++b)
#pragma unroll
                for (int m = 0; m < 4; ++m)
#pragma unroll
                    for (int n = 0; n < 2; ++n) acc[a][b][m][n] = acc_[a][b][m][n] * asc;
        if (pn < 8) {
            const bool isk = pn >= 4; const float* gain = isk ? kg : qg; const float sc = isk ? 1.0f : 0.125f * 1.4426950408889634f;
            f32x4 gv[2][2];
#pragma unroll
            for (int bj = 0; bj < 2; ++bj)
#pragma unroll
                for (int n = 0; n < 2; ++n) gv[bj][n] = *(const f32x4*)(gain + 32 * bj + 8 * fq + 4 * n) * sc;
#pragma unroll
            for (int ai = 0; ai < 2; ++ai)
#pragma unroll
                for (int m = 0; m < 4; ++m) {
                    float ss = 0.f;
#pragma unroll
                    for (int bj = 0; bj < 2; ++bj)
#pragma unroll
                        for (int n = 0; n < 2; ++n) { const f32x4 v = acc[ai][bj][m][n]; ss += (v[0] * v[0] + v[1] * v[1]) + (v[2] * v[2] + v[3] * v[3]); }
                    ss += __shfl_xor(ss, 16); ss += __shfl_xor(ss, 32);
                    const float rstd = 1.0f / sqrtf(ss * (1.0f / 64.0f) + 1e-6f);
                    bf16_t* rowp = P5 + (size_t)(row0 + ai * HALF + m * 16) * 5120 + pn * BM + 64 * wc + 8 * fq;
#pragma unroll
                    for (int bj = 0; bj < 2; ++bj) { const f32x4 v0 = acc[ai][bj][m][0] * rstd * gv[bj][0], v1 = acc[ai][bj][m][1] * rstd * gv[bj][1];
                        u32x4 w; w.x = cvt_pk_bf16(v0[0], v0[1]); w.y = cvt_pk_bf16(v0[2], v0[3]); w.z = cvt_pk_bf16(v1[0], v1[1]); w.w = cvt_pk_bf16(v1[2], v1[3]);
                        *(u32x4*)(rowp + 32 * bj) = w; }
                }
        } else if (pn < 20) {
            const bool gl = pn >= 16; const int col0 = pn * BM + wc * 32 + 8 * fq;
#pragma unroll
            for (int ai = 0; ai < 2; ++ai)
#pragma unroll
                for (int m = 0; m < 4; ++m) { bf16_t* rowp = P5 + (size_t)(row0 + ai * HALF + m * 16) * 5120 + col0;
#pragma unroll
                    for (int bj = 0; bj < 2; ++bj) { f32x4 v0 = acc[ai][bj][m][0], v1 = acc[ai][bj][m][1];
                        if (gl) { v0 = (f32x4){gelu_t(v0[0]), gelu_t(v0[1]), gelu_t(v0[2]), gelu_t(v0[3])}; v1 = (f32x4){gelu_t(v1[0]), gelu_t(v1[1]), gelu_t(v1[2]), gelu_t(v1[3])}; }
                        u32x4 w; w.x = cvt_pk_bf16(v0[0], v0[1]); w.y = cvt_pk_bf16(v0[2], v0[3]); w.z = cvt_pk_bf16(v1[0], v1[1]); w.w = cvt_pk_bf16(v1[2], v1[3]);
                        *(u32x4*)(rowp + bj * HALF) = w; } }
        } else {
            const int col0 = (pn - 20) * BM + wc * 32 + 8 * fq;
            f32x4 bv[2][2];
#pragma unroll
            for (int bj = 0; bj < 2; ++bj)
#pragma unroll
                for (int n = 0; n < 2; ++n) bv[bj][n] = *(const f32x4*)(bgate + col0 + bj * HALF + 4 * n);
#pragma unroll
            for (int ai = 0; ai < 2; ++ai)
#pragma unroll
                for (int m = 0; m < 4; ++m) { unsigned char* rowp = (unsigned char*)G + (size_t)(row0 + ai * HALF + m * 16) * 4096 + col0;
#pragma unroll
                    for (int bj = 0; bj < 2; ++bj) { const f32x4 v0 = acc[ai][bj][m][0] + bv[bj][0], v1 = acc[ai][bj][m][1] + bv[bj][1];
                        typedef unsigned u32x2 __attribute__((ext_vector_type(2))); u32x2 w;
                        w.x = q8(v0[0]) | (q8(v0[1]) << 8) | (q8(v0[2]) << 16) | (q8(v0[3]) << 24); w.y = q8(v1[0]) | (q8(v1[1]) << 8) | (q8(v1[2]) << 16) | (q8(v1[3]) << 24);
                        *(u32x2*)(rowp + bj * HALF) = w; } }
        }
    }
};
template <int MODE> struct EpiMix {
    static constexpr bool PERM = true, AFTER_DRAIN = false;
    bf16_t* O; const bf16_t* G; const bf16_t* prev; int goff;
    static __device__ __forceinline__ float lo(unsigned w) { return __uint_as_float(w << 16); }
    static __device__ __forceinline__ float hi(unsigned w) { return __uint_as_float(w & 0xffff0000u); }
    __device__ __forceinline__ void operator()(const f32x4 (&acc)[2][2][4][2], const Unit& u, int wr, int wc, int fr, int fq) const {
        const int row0 = u.pm * BM + wr * 64 + fr, col0 = u.pn * BM + wc * 32 + 8 * fq;
#pragma unroll
        for (int ai = 0; ai < 2; ++ai)
#pragma unroll
            for (int m = 0; m < 4; ++m) { const size_t row = (size_t)(row0 + ai * HALF + m * 16);
#pragma unroll
                for (int bj = 0; bj < 2; ++bj) { typedef unsigned u32x2 __attribute__((ext_vector_type(2))); const u32x2 gw = *(const u32x2*)((const unsigned char*)G + row * 4096 + goff + col0 + bj * HALF);
                    f32x4 v0 = acc[ai][bj][m][0] * (1.0f / 255.0f), v1 = acc[ai][bj][m][1] * (1.0f / 255.0f);
                    v0 = (f32x4){v0[0] * (float)(gw.x & 0xffu), v0[1] * (float)((gw.x >> 8) & 0xffu), v0[2] * (float)((gw.x >> 16) & 0xffu), v0[3] * (float)(gw.x >> 24)}; v1 = (f32x4){v1[0] * (float)(gw.y & 0xffu), v1[1] * (float)((gw.y >> 8) & 0xffu), v1[2] * (float)((gw.y >> 16) & 0xffu), v1[3] * (float)(gw.y >> 24)};
                    if (MODE == 1) { const u32x4 pw = *(const u32x4*)(prev + row * 2048 + col0 + bj * HALF);
                        v0 = v0 + (f32x4){lo(pw.x), hi(pw.x), lo(pw.y), hi(pw.y)}; v1 = v1 + (f32x4){lo(pw.z), hi(pw.z), lo(pw.w), hi(pw.w)}; }
                    u32x4 w; w.x = cvt_pk_bf16(v0[0], v0[1]); w.y = cvt_pk_bf16(v0[2], v0[3]); w.z = cvt_pk_bf16(v1[0], v1[1]); w.w = cvt_pk_bf16(v1[2], v1[3]);
                    *(u32x4*)(O + row * 2048 + col0 + bj * HALF) = w; } }
    }
};
struct EpiMix2 {
    static constexpr bool PERM = true, AFTER_DRAIN = false, KEEP_ACC = true;
    bf16_t* O; const unsigned char* G8;
    typedef unsigned u32x2 __attribute__((ext_vector_type(2)));
    static __device__ __forceinline__ float ub(unsigned w, int i) { return (float)((w >> (8 * i)) & 0xffu); }
    __device__ __forceinline__ void mid(f32x4 (&acc)[2][2][4][2], const Unit& u, int wr, int wc, int fr, int fq) const {
        const int row0 = u.pm * BM + wr * 64 + fr, col0 = u.pn * BM + wc * 32 + 8 * fq;
#pragma unroll
        for (int ai = 0; ai < 2; ++ai)
#pragma unroll
            for (int m = 0; m < 4; ++m) { const unsigned char* gp = G8 + (size_t)(row0 + ai * HALF + m * 16) * 4096 + col0;
#pragma unroll
                for (int bj = 0; bj < 2; ++bj) { const u32x2 g0 = *(const u32x2*)(gp + bj * HALF), g1 = *(const u32x2*)(gp + 2048 + bj * HALF);
#pragma unroll
                    for (int j = 0; j < 4; ++j) { acc[ai][bj][m][0][j] *= ub(g0.x, j) * __builtin_amdgcn_rcpf(ub(g1.x, j)); acc[ai][bj][m][1][j] *= ub(g0.y, j) * __builtin_amdgcn_rcpf(ub(g1.y, j)); } } }
    }
    __device__ __forceinline__ void operator()(const f32x4 (&acc)[2][2][4][2], const Unit& u, int wr, int wc, int fr, int fq) const {
        const int row0 = u.pm * BM + wr * 64 + fr, col0 = u.pn * BM + wc * 32 + 8 * fq;
#pragma unroll
        for (int ai = 0; ai < 2; ++ai)
#pragma unroll
            for (int m = 0; m < 4; ++m) { const size_t row = (size_t)(row0 + ai * HALF + m * 16);
#pragma unroll
                for (int bj = 0; bj < 2; ++bj) { const u32x2 g1 = *(const u32x2*)(G8 + row * 4096 + 2048 + col0 + bj * HALF);
                    f32x4 v0 = acc[ai][bj][m][0] * (1.0f / 255.0f), v1 = acc[ai][bj][m][1] * (1.0f / 255.0f);
                    v0 = (f32x4){v0[0] * ub(g1.x, 0), v0[1] * ub(g1.x, 1), v0[2] * ub(g1.x, 2), v0[3] * ub(g1.x, 3)}; v1 = (f32x4){v1[0] * ub(g1.y, 0), v1[1] * ub(g1.y, 1), v1[2] * ub(g1.y, 2), v1[3] * ub(g1.y, 3)};
                    u32x4 w; w.x = cvt_pk_bf16(v0[0], v0[1]); w.y = cvt_pk_bf16(v0[2], v0[3]); w.z = cvt_pk_bf16(v1[0], v1[1]); w.w = cvt_pk_bf16(v1[2], v1[3]);
                    *(u32x4*)(O + row * 2048 + col0 + bj * HALF) = w; } }
    }
};
struct EpiF32Res {
    static constexpr bool PERM = false, AFTER_DRAIN = false;
    float* C; int ldc; const float* res;
    __device__ __forceinline__ void operator()(const f32x4 (&acc)[2][2][4][2], const Unit& u, int wr, int wc, int fr, int fq) const {
        const int row0 = u.pm * BM + wr * 64 + fr, col0 = u.pn * BM + wc * 32 + 4 * fq;
#pragma unroll
        for (int ai = 0; ai < 2; ++ai)
#pragma unroll
            for (int m = 0; m < 4; ++m) { const size_t off = (size_t)(row0 + ai * HALF + m * 16) * ldc + col0;
#pragma unroll
                for (int bj = 0; bj < 2; ++bj)
#pragma unroll
                    for (int n = 0; n < 2; ++n) { const f32x4 r = *(const f32x4*)(res + off + bj * HALF + n * 16); *(f32x4*)(C + off + bj * HALF + n * 16) = acc[ai][bj][m][n] + r; } }
    }
};
struct EpiBf16Res {
    static constexpr bool PERM = true, AFTER_DRAIN = false;
    bf16_t* O; const float* res;
    __device__ __forceinline__ void operator()(const f32x4 (&acc)[2][2][4][2], const Unit& u, int wr, int wc, int fr, int fq) const {
        const int row0 = u.pm * BM + wr * 64 + fr, col0 = u.pn * BM + wc * 32 + 8 * fq;
#pragma unroll
        for (int ai = 0; ai < 2; ++ai)
#pragma unroll
            for (int m = 0; m < 4; ++m) { const size_t off = (size_t)(row0 + ai * HALF + m * 16) * 2048 + col0;
#pragma unroll
                for (int bj = 0; bj < 2; ++bj) { const f32x4 r0 = *(const f32x4*)(res + off + bj * HALF), r1 = *(const f32x4*)(res + off + bj * HALF + 4);
                    const f32x4 v0 = acc[ai][bj][m][0] + r0, v1 = acc[ai][bj][m][1] + r1;
                    u32x4 w; w.x = cvt_pk_bf16(v0[0], v0[1]); w.y = cvt_pk_bf16(v0[2], v0[3]); w.z = cvt_pk_bf16(v1[0], v1[1]); w.w = cvt_pk_bf16(v1[2], v1[3]);
                    *(u32x4*)(O + off + bj * HALF) = w; } }
    }
};
struct EpiSwiglu {
    static constexpr bool PERM = true, AFTER_DRAIN = false;
    unsigned char* O; const float* b1; const PG8_LAS int* texp; const float* rstd; const PG8_LAS int* tokt;
    static __device__ __forceinline__ float sw(float g, float l) { g = fminf(g, 7.0f); l = fminf(fmaxf(l, -7.0f), 7.0f); return fminf(fmaxf(8.0f * g * __builtin_amdgcn_rcpf(1.0f + __expf(-1.702f * g)) * (l + 1.0f), -448.0f), 448.0f); }
    __device__ __forceinline__ void operator()(const f32x4 (&acc)[2][2][4][2], const Unit& u, int wr, int wc, int fr, int fq) const {
        const int e = texp[u.pm]; const float* bias = b1 + (size_t)e * 4096;
        const int row0 = u.pm * BM + wr * 64 + fr, col0 = u.pn * BM + wc * 32 + 8 * fq;
        f32x4 bv[2][2];
#pragma unroll
        for (int bj = 0; bj < 2; ++bj)
#pragma unroll
            for (int n = 0; n < 2; ++n) bv[bj][n] = *(const f32x4*)(bias + col0 + bj * HALF + 4 * n);
#pragma unroll
        for (int ai = 0; ai < 2; ++ai)
#pragma unroll
            for (int m = 0; m < 4; ++m) { unsigned char* rowp = O + (size_t)(row0 + ai * HALF + m * 16) * 2048 + (col0 >> 1); const float rsc = rstd[tokt[u.slot * 256 + wr * 64 + fr + ai * HALF + m * 16]] * (1.0f / 8192.0f);
#pragma unroll
                for (int bj = 0; bj < 2; ++bj) { const f32x4 v0 = acc[ai][bj][m][0] * rsc + bv[bj][0], v1 = acc[ai][bj][m][1] * rsc + bv[bj][1];
                    int w = __builtin_amdgcn_cvt_pk_fp8_f32(sw(v0[0], v0[1]), sw(v0[2], v0[3]), 0, false); w = __builtin_amdgcn_cvt_pk_fp8_f32(sw(v1[0], v1[1]), sw(v1[2], v1[3]), w, true);
                    *(int*)(rowp + bj * 64) = w; } }
    }
};
struct EpiEo {
    static constexpr bool PERM = true, AFTER_DRAIN = false;
    unsigned char* O; const float* b2; const PG8_LAS int* texp;
    static __device__ __forceinline__ float s8(float v) { return fminf(fmaxf(32.0f * v, -448.0f), 448.0f); }
    __device__ __forceinline__ void operator()(const f32x4 (&acc)[2][2][4][2], const Unit& u, int wr, int wc, int fr, int fq) const {
        const int e = texp[u.pm]; const float* bias = b2 + (size_t)e * 2048;
        const int row0 = u.pm * BM + wr * 64 + fr, col0 = u.pn * BM + wc * 32 + 8 * fq;
        f32x4 bv[2][2];
#pragma unroll
        for (int bj = 0; bj < 2; ++bj)
#pragma unroll
            for (int n = 0; n < 2; ++n) bv[bj][n] = *(const f32x4*)(bias + col0 + bj * HALF + 4 * n);
#pragma unroll
        for (int ai = 0; ai < 2; ++ai)
#pragma unroll
            for (int m = 0; m < 4; ++m) { int qa[2], qb[2];
#pragma unroll
                for (int bj = 0; bj < 2; ++bj) { const f32x4 v0 = acc[ai][bj][m][0] * (1.0f / 4096.0f) + bv[bj][0], v1 = acc[ai][bj][m][1] * (1.0f / 4096.0f) + bv[bj][1];
                    int a = __builtin_amdgcn_cvt_pk_fp8_f32(s8(v0[0]), s8(v0[1]), 0, false); a = __builtin_amdgcn_cvt_pk_fp8_f32(s8(v0[2]), s8(v0[3]), a, true);
                    int b = __builtin_amdgcn_cvt_pk_fp8_f32(s8(v1[0]), s8(v1[1]), 0, false); b = __builtin_amdgcn_cvt_pk_fp8_f32(s8(v1[2]), s8(v1[3]), b, true); qa[bj] = a; qb[bj] = b; }
                auto sa = __builtin_amdgcn_permlane16_swap((unsigned)qa[0], (unsigned)qa[1], false, false); auto sb = __builtin_amdgcn_permlane16_swap((unsigned)qb[0], (unsigned)qb[1], false, false);
                *(u32x4*)(O + (size_t)(row0 + ai * HALF + m * 16) * 2048 + u.pn * BM + wc * 32 + 8 * (fq & ~1) + HALF * (fq & 1)) = (u32x4){sa[0], sb[0], sa[1], sb[1]}; }
    }
};
}

DEV void p0_transpose_item(const float* W, int K, int N, bf16* WT, LAS float* scr, int item, int lane, bool qkperm = false, int NC = 0) {
    const int nblk = (NC ? NC : N) / 32, kb = item / nblk, nb = item % nblk, k0 = 64 * kb, n0 = 32 * nb;
    const int d0 = (qkperm && n0 < 2048) ? (n0 & ~255) + 128 * ((n0 >> 5) & 1) + 32 * ((n0 >> 6) & 3) : n0;
#pragma unroll 8
    for (int i = 0; i < 32; ++i) { const int kk = 2 * i + (lane >> 5); scr[kk * 33 + (lane & 31)] = W[(size_t)(k0 + kk) * N + n0 + (lane & 31)]; }
    LDS_WAIT(); asm volatile("" ::: "memory");
    const int c = lane & 7;
#pragma unroll
    for (int j = 0; j < 4; ++j) { const int n = (lane >> 3) + 8 * j; const LAS float* s = scr + (8 * c) * 33 + n;
        v4u o; o.x = pk2(s[0 * 33], s[1 * 33]); o.y = pk2(s[2 * 33], s[3 * 33]); o.z = pk2(s[4 * 33], s[5 * 33]); o.w = pk2(s[6 * 33], s[7 * 33]);
        *(GAS v4u*)(WT + (size_t)(d0 + n) * K + k0 + 8 * c) = o; }
    LDS_WAIT(); asm volatile("" ::: "memory");
}
DEV int pk4_fp8(float a, float b, float c, float d) { int w = __builtin_amdgcn_cvt_pk_fp8_f32(a, b, 0, false); return __builtin_amdgcn_cvt_pk_fp8_f32(c, d, w, true); }
DEV float sat8(float v) { return fminf(fmaxf(v, -448.0f), 448.0f); }
DEV void p0_transpose_item8(const float* W, int K, int N, unsigned char* WT8, LAS float* scr, int item, int lane, float scale) {
    const int nblk = N / 32, kb = item / nblk, nb = item % nblk, k0 = 64 * kb, n0 = 32 * nb;
#pragma unroll 8
    for (int i = 0; i < 32; ++i) { const int kk = 2 * i + (lane >> 5); scr[kk * 33 + (lane & 31)] = W[(size_t)(k0 + kk) * N + n0 + (lane & 31)]; }
    LDS_WAIT(); asm volatile("" ::: "memory");
#pragma unroll
    for (int j = 0; j < 2; ++j) { const int cid = lane + 64 * j, n = cid >> 2, c = cid & 3; const LAS float* s = scr + (16 * c) * 33 + n;
        v4u o;
        o.x = (unsigned)pk4_fp8(sat8(s[0 * 33] * scale), sat8(s[1 * 33] * scale), sat8(s[2 * 33] * scale), sat8(s[3 * 33] * scale));
        o.y = (unsigned)pk4_fp8(sat8(s[4 * 33] * scale), sat8(s[5 * 33] * scale), sat8(s[6 * 33] * scale), sat8(s[7 * 33] * scale));
        o.z = (unsigned)pk4_fp8(sat8(s[8 * 33] * scale), sat8(s[9 * 33] * scale), sat8(s[10 * 33] * scale), sat8(s[11 * 33] * scale));
        o.w = (unsigned)pk4_fp8(sat8(s[12 * 33] * scale), sat8(s[13 * 33] * scale), sat8(s[14 * 33] * scale), sat8(s[15 * 33] * scale));
        *(GAS v4u*)(WT8 + (size_t)(n0 + n) * K + k0 + 16 * c) = o; }
    LDS_WAIT(); asm volatile("" ::: "memory");
}
DEV void p0_tr8_item(const float* W, int K, int N, unsigned char* WT8, int item, int lane, float scale, int NC = 0, bool qkperm = false) {
    const int nblk = (NC ? NC : N) / 64, kb = item / nblk, nb = item % nblk, k0 = 128 * kb, n0 = 64 * nb, lg = lane >> 4, lc = lane & 15;
    const float* src = W + (size_t)(k0 + 32 * lg) * N + n0 + 4 * lc;
    f32x4 v[32];
#pragma unroll
    for (int i = 0; i < 32; ++i) v[i] = __builtin_nontemporal_load((const GAS f32x4*)(src + (size_t)i * N));
#pragma unroll
    for (int j = 0; j < 4; ++j) { unsigned w[8];
#pragma unroll
        for (int q = 0; q < 8; ++q) w[q] = (unsigned)pk4_fp8(sat8(v[4 * q][j] * scale), sat8(v[4 * q + 1][j] * scale), sat8(v[4 * q + 2][j] * scale), sat8(v[4 * q + 3][j] * scale));
        int nrow = n0 + 4 * lc + j; if (qkperm && nrow < 2048) { const int c = nrow & 255; nrow = (nrow & ~255) + 128 * ((c >> 5) & 1) + 32 * (c >> 6) + (c & 31); }
        GAS v4u* dst = (GAS v4u*)(WT8 + (size_t)nrow * K + k0 + 32 * lg);
        dst[0] = (v4u){w[0], w[1], w[2], w[3]}; dst[1] = (v4u){w[4], w[5], w[6], w[7]}; }
}
DEV void p0_tr16_item(const float* W, int K, int N, bf16* WT, int item, int lane, int NC, bool qkperm) {
    const int nblk = NC / 64, kb = item / nblk, nb = item % nblk, k0 = 128 * kb, n0 = 64 * nb, lg = lane >> 4, lc = lane & 15;
    const float* src = W + (size_t)(k0 + 32 * lg) * N + n0 + 4 * lc;
    f32x4 v[32];
#pragma unroll
    for (int i = 0; i < 32; ++i) v[i] = *(const GAS f32x4*)(src + (size_t)i * N);
#pragma unroll
    for (int j = 0; j < 4; ++j) {
        int nrow = n0 + 4 * lc + j; if (qkperm && nrow < 2048) { const int c = nrow & 255; nrow = (nrow & ~255) + 128 * ((c >> 5) & 1) + 32 * (c >> 6) + (c & 31); }
        GAS v4u* dst = (GAS v4u*)(WT + (size_t)nrow * K + k0 + 32 * lg);
#pragma unroll
        for (int q = 0; q < 4; ++q) { v4u o; o.x = pk2(v[8 * q][j], v[8 * q + 1][j]); o.y = pk2(v[8 * q + 2][j], v[8 * q + 3][j]); o.z = pk2(v[8 * q + 4][j], v[8 * q + 5][j]); o.w = pk2(v[8 * q + 6][j], v[8 * q + 7][j]); dst[q] = o; }
    }
}
DEV void p0_tr16_item_h(const float* W, int K, int N, bf16* WT, int item, int lane, int NC) {
    const int nblk = NC / 64, kb = item / nblk, nb = item % nblk, k0 = 128 * kb, n0 = 64 * nb, lg = lane >> 4, lc = lane & 15;
#pragma unroll 1
    for (int hf = 0; hf < 2; ++hf) {
        const float* src = W + (size_t)(k0 + 32 * lg + 16 * hf) * N + n0 + 4 * lc;
        f32x4 v[16];
#pragma unroll
        for (int i = 0; i < 16; ++i) v[i] = *(const GAS f32x4*)(src + (size_t)i * N);
#pragma unroll
        for (int j = 0; j < 4; ++j) { GAS v4u* dst = (GAS v4u*)(WT + (size_t)(n0 + 4 * lc + j) * K + k0 + 32 * lg + 16 * hf);
            v4u o0, o1; o0.x = pk2(v[0][j], v[1][j]); o0.y = pk2(v[2][j], v[3][j]); o0.z = pk2(v[4][j], v[5][j]); o0.w = pk2(v[6][j], v[7][j]);
            o1.x = pk2(v[8][j], v[9][j]); o1.y = pk2(v[10][j], v[11][j]); o1.z = pk2(v[12][j], v[13][j]); o1.w = pk2(v[14][j], v[15][j]); dst[0] = o0; dst[1] = o1; }
    }
}
DEV void p0_tr8_item_h(const float* W, int K, int N, unsigned char* WT8, int item, int lane, float scale) {
    const int nblk = N / 64, kb = item / nblk, nb = item % nblk, k0 = 128 * kb, n0 = 64 * nb, lg = lane >> 4, lc = lane & 15;
#pragma unroll 1
    for (int hf = 0; hf < 2; ++hf) {
        const float* src = W + (size_t)(k0 + 32 * lg + 16 * hf) * N + n0 + 4 * lc;
        f32x4 v[16];
#pragma unroll
        for (int i = 0; i < 16; ++i) v[i] = __builtin_nontemporal_load((const GAS f32x4*)(src + (size_t)i * N));
#pragma unroll
        for (int j = 0; j < 4; ++j) { v4u o;
            o.x = (unsigned)pk4_fp8(sat8(v[0][j] * scale), sat8(v[1][j] * scale), sat8(v[2][j] * scale), sat8(v[3][j] * scale)); o.y = (unsigned)pk4_fp8(sat8(v[4][j] * scale), sat8(v[5][j] * scale), sat8(v[6][j] * scale), sat8(v[7][j] * scale));
            o.z = (unsigned)pk4_fp8(sat8(v[8][j] * scale), sat8(v[9][j] * scale), sat8(v[10][j] * scale), sat8(v[11][j] * scale)); o.w = (unsigned)pk4_fp8(sat8(v[12][j] * scale), sat8(v[13][j] * scale), sat8(v[14][j] * scale), sat8(v[15][j] * scale));
            *(GAS v4u*)(WT8 + (size_t)(n0 + 4 * lc + j) * K + k0 + 32 * lg + 16 * hf) = o; }
    }
}
namespace pg8 {
template <int K, int N, int NSL, int IPS> struct ConvOrder : StaticOrder {
    const float* const __attribute__((address_space(4)))* wsrc; unsigned char* const __attribute__((address_space(4)))* wsp; size_t wsoff; int ub; mutable int ucount;
    __device__ __forceinline__ void done(const Unit&) const {
        const int gi = ub + ucount; ++ucount;
        if (gi >= 0 && (gi & 3) == 0 && (gi >> 2) < NSL) { constexpr int per_e = (K / 128) * (N / 64); const int s = gi >> 2;
            int tx = threadIdx.x; asm volatile("" : "+v"(tx) :: "memory");
            const int lane = tx & 63, gw = blockIdx.x * 8 + __builtin_amdgcn_readfirstlane(tx >> 6), NGW = gridDim.x * 8;
            const float* W = *wsrc; unsigned char* WT8 = *wsp + wsoff;
            for (int k = s * IPS; k < (s + 1) * IPS; ++k) { const int it = gw + k * NGW; if (it < NE * per_e) { const int e = it / per_e;
                p0_tr8_item_h(W + (size_t)e * K * N, K, N, WT8 + (size_t)e * K * N, it % per_e, lane, 512.0f); } } }
    }
};
template <int K, int N, int NSL, int IPS> struct GatherOrder : ConvOrder<K, N, NSL, IPS> {
    static constexpr bool GATHER = true;
    PG8_LAS unsigned char* ldsb;
    __device__ __forceinline__ void fill(int slot, int pm) const {
        const int tid = threadIdx.x;
        if (tid < 256) { const PG8_LAS int* pads = (const PG8_LAS int*)(ldsb + PADS_OFF); const PG8_LAS int* cl = (const PG8_LAS int*)(ldsb + CNTL_OFF);
            const __attribute__((address_space(4))) unsigned long long* kp = (const __attribute__((address_space(4))) unsigned long long*)__builtin_amdgcn_kernarg_segment_ptr();
            const int* tok_by_e = (const int*)((const unsigned char*)kp[30] + WS_ROUTE) + 3 * T * TOPK;
            const int e = this->texp[pm], idx = pm * 256 + tid - pads[e]; ((PG8_LAS int*)(ldsb + TOKT_OFF))[slot * 256 + tid] = idx < cl[e] ? tok_by_e[(size_t)e * T + idx] : 0; }
    }
    __device__ __forceinline__ int tokrow(int slot, int row) const { return ((const PG8_LAS int*)(ldsb + TOKT_OFF))[slot * 256 + row]; }
    __device__ __forceinline__ void gather_init(const Unit& u) const {
        fill(0, u.pm); Unit u1; if (this->next(1, u1)) fill(1, u1.pm); asm volatile("s_waitcnt vmcnt(0) lgkmcnt(0)" ::: "memory"); __builtin_amdgcn_s_barrier(); asm volatile("" ::: "memory");
    }
    __device__ __forceinline__ void done(const Unit& u) const {
        const int n = this->ucount;
        ConvOrder<K, N, NSL, IPS>::done(u);
        Unit u2; if (this->next(n + 2, u2)) fill(u2.slot, u2.pm);
    }
};
}
DEV void rms_row_to_bf16(const float* xrow, const float* gain, bf16* orow, unsigned char* orow8, int lane) {
    const GAS f32x4* xr = (const GAS f32x4*)xrow + lane; const GAS f32x4* gr = (const GAS f32x4*)gain + lane;
    f32x4 v[8]; float s = 0.f;
#pragma unroll
    for (int j = 0; j < 8; ++j) { v[j] = xr[64 * j]; s += (v[j].x * v[j].x + v[j].y * v[j].y) + (v[j].z * v[j].z + v[j].w * v[j].w); }
    const float rstd = 1.0f / sqrtf(wave_sum(s) * (1.f / D) + RMS_EPS);
    GAS v2u* o8 = (GAS v2u*)orow + lane;
#pragma unroll
    for (int j = 0; j < 8; ++j) { const f32x4 g = gr[64 * j]; const float a = v[j].x * rstd * g.x, b = v[j].y * rstd * g.y, c = v[j].z * rstd * g.z, d = v[j].w * rstd * g.w; v2u o; o.x = pk2(a, b); o.y = pk2(c, d); if (orow) o8[64 * j] = o;
        ((GAS unsigned*)orow8 + lane)[64 * j] = (unsigned)pk4_fp8(sat8(16.0f * a), sat8(16.0f * b), sat8(16.0f * c), sat8(16.0f * d)); }
}


typedef float f32x16 __attribute__((ext_vector_type(16)));
typedef short bf16x8 __attribute__((ext_vector_type(8)));
typedef short s16x4 __attribute__((ext_vector_type(4)));
typedef float f32x2_t __attribute__((ext_vector_type(2))); typedef __bf16 bf16x2_t __attribute__((ext_vector_type(2)));
constexpr float LOG2E = 1.4426950408889634f;
constexpr int AT_STAGE = 32768, AT_LUT = 2 * AT_STAGE, AT_LSC = AT_LUT + 1280, AT_BYTES = AT_LSC + 2048;
DEV unsigned off_a(unsigned row, unsigned ch) { return 2048u * (row >> 3) + 512u * (ch >> 2) + 64u * (row & 7) + 16u * ((ch & 3) ^ ((row >> 2) & 3)); }
DEV unsigned cvtpk_s(float lo, float hi) { f32x2_t v = {lo, hi}; bf16x2_t b = __builtin_convertvector(v, bf16x2_t); return __builtin_bit_cast(unsigned, b); }
DEV s16x4 vtr(const LAS unsigned char* p) { return __builtin_bit_cast(s16x4, __builtin_amdgcn_ds_read_tr16_b64_v4i16((LAS s16x4*)p)); }
DEV bf16x8 pack8(const f32x16& x, int s) {
    v4u p; p.x = cvtpk_s(x[8 * s], x[8 * s + 1]); p.y = cvtpk_s(x[8 * s + 2], x[8 * s + 3]); p.z = cvtpk_s(x[8 * s + 4], x[8 * s + 5]); p.w = cvtpk_s(x[8 * s + 6], x[8 * s + 7]);
    return __builtin_bit_cast(bf16x8, p);
}
#define MFMA32(a, b, c) __builtin_amdgcn_mfma_f32_32x32x16_bf16((a), (b), (c), 0, 0, 0)

DEV void attn_unit(LAS unsigned char* lds, int b, int h, int qblk, const bf16* Qb, const bf16* Kb, const bf16* Vb, int vpitch, bf16* OAB,
                   const float* table, const float* sub_gain, float lam, float shift, int tid, int lane, int wave) {
    asm volatile("" : "+v"(lane), "+v"(tid));
    const int r = lane & 31, hh = lane >> 5;
    const int q0w = 256 * qblk + 32 * wave;
    const int cq = q0w >> 6;
    const int ntile = 4 * qblk + 4;
    const size_t rowb = (size_t)b * SEQ;
    LAS float* lut = (LAS float*)(lds + AT_LUT);
    for (int i = tid; i < 320; i += NTHR) lut[i] = table[t5_bucket(i - 255) * 8 + h] * LOG2E - shift;
    bf16x8 qf[2][4];
    { const bf16* qrow = Qb + (rowb + q0w + r) * (size_t)vpitch + h * 128 + 8 * hh;
#pragma unroll
      for (int mm = 0; mm < 2; ++mm)
#pragma unroll
          for (int ks = 0; ks < 4; ++ks) qf[mm][ks] = *(const bf16x8*)(qrow + mm * 64 + 16 * ks); }
    const int srow = 8 * wave + ((lane & 31) >> 2), sch = 4 * (lane >> 5) + ((lane & 3) ^ ((srow >> 2) & 3));
    const bf16* kg = Kb + (rowb + srow) * (size_t)vpitch + h * 128 + sch * 8;
    const bf16* vg = Vb + (rowb + srow) * (size_t)vpitch + h * 128 + sch * 8;
    const int sdst = 2048 * wave;
#define AT_G16(gp, ldsoff) do { unsigned keep_; asm volatile("s_mov_b32 %0, m0\n\ts_mov_b32 m0, %2\n\ts_nop 0\n\tglobal_load_lds_dwordx4 %1, off\n\ts_mov_b32 m0, %0" : "=&s"(keep_) : "v"(gp), "s"(ldsoff) : "memory"); } while (0)
#define AT_DMA(j, buf) do { const unsigned sb_ = (unsigned)__builtin_amdgcn_readfirstlane((int)(unsigned)(unsigned long)(lds + (buf) * AT_STAGE + sdst)); \
        AT_G16(kg + (size_t)(j) * 64 * vpitch, sb_); AT_G16(kg + (size_t)(j) * 64 * vpitch + 64, sb_ + 1024u); \
        AT_G16(vg + (size_t)(j) * 64 * vpitch, sb_ + 16384u); AT_G16(vg + (size_t)(j) * 64 * vpitch + 64, sb_ + 16384u + 1024u); } while (0)
    AT_DMA(0, 0);
    VM_WAIT();
#pragma unroll
    for (int mm = 0; mm < 2; ++mm)
#pragma unroll
        for (int ks = 0; ks < 4; ++ks) asm volatile("" : "+v"(qf[mm][ks]));
    __syncthreads();
    f32x16 O[2][4];
#pragma unroll
    for (int mm = 0; mm < 2; ++mm)
#pragma unroll
        for (int d = 0; d < 4; ++d)
#pragma unroll
            for (int i = 0; i < 16; ++i) O[mm][d][i] = 0.f;
    float ls0 = 0.f, ls1 = 0.f;
    unsigned kad0, kad1, vad0, vad1;
    { const int blk = (lane >> 4) & 1, tq = (lane & 15) >> 2, tp = lane & 3;
      kad0 = off_a(r, hh); kad1 = off_a(r, 2 + hh);
      vad0 = off_a(4 * hh + tq, 2 * blk + (tp >> 1)) + 8 * (tp & 1); vad1 = off_a(8 + 4 * hh + tq, 2 * blk + (tp >> 1)) + 8 * (tp & 1); }
    for (int j = 0; j < ntile; ++j) {
        const bool more = (j + 1 < ntile);
        if (more) AT_DMA(j + 1, (j + 1) & 1);
        if (j <= cq) {
            const LAS unsigned char* Ks = lds + (j & 1) * AT_STAGE; const LAS unsigned char* Vs = Ks + 16384;
            const bool nearb = (j + 2 >= cq);
#pragma unroll 1
            for (int kb = 0; kb < 2; ++kb) {
                bf16x8 pf[2][2];
#pragma unroll
                for (int mm = 0; mm < 2; ++mm) {
                    f32x16 sa;
                    if (nearb) { const int base = 64 * j + 32 * kb + 4 * hh - q0w - r + 255;
#pragma unroll
                        for (int i = 0; i < 16; ++i) sa[i] = lut[base + (i & 3) + 8 * (i >> 2)]; }
                    else { const float cfar = lut[0];
#pragma unroll
                        for (int i = 0; i < 16; ++i) sa[i] = cfar; }
#pragma unroll
                    for (int ks = 0; ks < 4; ++ks) {
                        const bf16x8 kf = *(const LAS bf16x8*)(Ks + 8192 * kb + ((ks & 1) ? kad1 : kad0) + 512 * (2 * mm + (ks >> 1)));
                        sa = MFMA32(kf, qf[mm][ks], sa);
                        if (ks == 1) __builtin_amdgcn_sched_barrier(0);
                    }
                    float lacc = 0.f;
#pragma unroll
                    for (int i = 0; i < 16; ++i) { sa[i] = __builtin_amdgcn_exp2f(sa[i]); lacc += sa[i]; }
                    if (mm == 0) ls0 += lacc; else ls1 += lacc;
                    pf[mm][0] = pack8(sa, 0); pf[mm][1] = pack8(sa, 1);
                }
#pragma unroll
                for (int s = 0; s < 2; ++s)
#pragma unroll
                    for (int d = 0; d < 4; ++d) {
                        const s16x4 lo = vtr(Vs + 8192 * kb + vad0 + 4096 * s + 512 * d);
                        const s16x4 hi = vtr(Vs + 8192 * kb + vad1 + 4096 * s + 512 * d);
                        const bf16x8 vf = __builtin_shufflevector(lo, hi, 0, 1, 2, 3, 4, 5, 6, 7);
                        O[0][d] = MFMA32(pf[0][s], vf, O[0][d]); O[1][d] = MFMA32(pf[1][s], vf, O[1][d]);
                        if (d == 1 || d == 3) __builtin_amdgcn_sched_barrier(0);
                    }
            }
        }
        VM_WAIT();
        __syncthreads();
    }
#undef AT_DMA
#undef AT_G16
    ls0 += __shfl_xor(ls0, 32); ls1 += __shfl_xor(ls1, 32);
    LAS float* lsc = (LAS float*)(lds + AT_LSC) + wave * 64;
    if (hh == 0) { lsc[r] = 1.0f / ls0; lsc[32 + r] = lam / ls1; }
    LDS_WAIT(); asm volatile("" ::: "memory");
    float sg[4];
#pragma unroll
    for (int d = 0; d < 4; ++d) sg[d] = sub_gain[32 * d + r] * 0.8f;
#pragma unroll
    for (int i = 0; i < 16; ++i) {
        const int q = (i & 3) + 8 * (i >> 2) + 4 * hh; const float a0 = lsc[q], a1 = lsc[32 + q];
        float o[4]; float ss = 0.f;
#pragma unroll
        for (int d = 0; d < 4; ++d) { o[d] = O[0][d][i] * a0 - O[1][d][i] * a1; ss += o[d] * o[d]; }
        ss += __shfl_xor(ss, 1); ss += __shfl_xor(ss, 2); ss += __shfl_xor(ss, 4); ss += __shfl_xor(ss, 8); ss += __shfl_xor(ss, 16);
        const float rstd = 1.0f / sqrtf(ss * (1.f / 128.f) + RMS_EPS);
        bf16* orow = OAB + (rowb + q0w + q) * 2048 + h * 128 + r;
#pragma unroll
        for (int d = 0; d < 4; ++d) orow[32 * d] = (bf16)f2bf(o[d] * rstd * sg[d]);
    }
    __syncthreads();
}

constexpr int AT3_QS = 65536, AT3_LUT = TOKT_OFF + 3072;
DEV void attn_unit3(LAS unsigned char* lds, int b, int h, int qblk, const bf16* Qb, const bf16* Kb, const bf16* Vb, int vpitch, bf16* OAB,
                   const float* table, const float* sub_gain, float lam, float shift, int tid, int lane, int wave) {
    asm volatile("" : "+v"(lane), "+v"(tid));
    const int r = lane & 31, hh = lane >> 5;
    const int q0w = 256 * qblk + 32 * wave;
    const int cq = q0w >> 6;
    const int ntile = 4 * qblk + 4;
    const size_t rowb = (size_t)b * SEQ;
    LAS float* lut = (LAS float*)(lds + AT3_LUT);
    for (int i = tid; i < 320; i += NTHR) lut[i] = table[t5_bucket(i - 255) * 8 + h] * LOG2E - shift;
    LAS unsigned char* qpark = lds + AT3_QS + wave * 8192 + lane * 16;
    { const bf16* qrow = Qb + (rowb + q0w + r) * (size_t)vpitch + h * 128 + 8 * hh;
#pragma unroll
      for (int mm = 0; mm < 2; ++mm)
#pragma unroll
          for (int ks = 0; ks < 4; ++ks) *(LAS bf16x8*)(qpark + (mm * 4 + ks) * 1024) = *(const bf16x8*)(qrow + mm * 64 + 16 * ks); }
    const int srow = 8 * wave + ((lane & 31) >> 2), sch = 4 * (lane >> 5) + ((lane & 3) ^ ((srow >> 2) & 3));
    const unsigned goff = (unsigned)(((size_t)srow * vpitch + h * 128 + sch * 8) * 2);
    const unsigned long long kbase = (unsigned long long)(Kb + rowb * (size_t)vpitch), vbase = (unsigned long long)(Vb + rowb * (size_t)vpitch);
    const int sdst = 2048 * wave;
#define AT_G16(sbase, ldsoff) do { unsigned keep_; asm volatile("s_mov_b32 %0, m0\n\ts_mov_b32 m0, %2\n\ts_nop 0\n\tglobal_load_lds_dwordx4 %1, %3\n\ts_mov_b32 m0, %4\n\ts_nop 0\n\tglobal_load_lds_dwordx4 %1, %5\n\ts_mov_b32 m0, %0" \
        : "=&s"(keep_) : "v"(goff), "s"(ldsoff), "s"(sbase), "s"((ldsoff) + 1024u), "s"((sbase) + 128ull) : "memory"); } while (0)
#define AT_DMA(j, buf) do { const unsigned sb_ = (unsigned)__builtin_amdgcn_readfirstlane((int)(unsigned)(unsigned long)(lds + (buf) * AT_STAGE + sdst)); \
        const unsigned long long tb_ = (unsigned long long)(j) * 64ull * (unsigned long long)vpitch * 2ull; \
        AT_G16(kbase + tb_, sb_); AT_G16(vbase + tb_, sb_ + 16384u); } while (0)
    AT_DMA(0, 0);
    VM_WAIT();
    __syncthreads();
    f32x16 O[2][4];
#pragma unroll
    for (int mm = 0; mm < 2; ++mm)
#pragma unroll
        for (int d = 0; d < 4; ++d)
#pragma unroll
            for (int i = 0; i < 16; ++i) O[mm][d][i] = 0.f;
    float ls0 = 0.f, ls1 = 0.f;
    unsigned kad0, vad0;
    { const int blk = (lane >> 4) & 1, tq = (lane & 15) >> 2, tp = lane & 3;
      kad0 = off_a(r, hh);
      vad0 = off_a(4 * hh + tq, 2 * blk + (tp >> 1)) + 8 * (tp & 1); }
#define kad1 (kad0 ^ 32u)
#define vad1 ((vad0 ^ 32u) + 2048u)
    for (int j = 0; j < ntile; ++j) {
        const bool more = (j + 1 < ntile);
        if (more) AT_DMA(j + 1, (j + 1) & 1);
        if (j <= cq) {
            const LAS unsigned char* Ks = lds + (j & 1) * AT_STAGE; const LAS unsigned char* Vs = Ks + 16384;
            const bool nearb = (j + 2 >= cq);
            f32x16 S[2][2];
#pragma unroll
            for (int kb = 0; kb < 2; ++kb) {
                if (nearb) { const int base = 64 * j + 32 * kb + 4 * hh - q0w - r + 255;
#pragma unroll
                    for (int i = 0; i < 16; ++i) { const float bv = lut[base + (i & 3) + 8 * (i >> 2)]; S[kb][0][i] = bv; S[kb][1][i] = bv; } }
                else { const float cfar = lut[0];
#pragma unroll
                    for (int i = 0; i < 16; ++i) { S[kb][0][i] = cfar; S[kb][1][i] = cfar; } }
            }
#pragma unroll
            for (int ks = 0; ks < 4; ++ks) {
                const bf16x8 q0 = *(const LAS bf16x8*)(qpark + ks * 1024), q1 = *(const LAS bf16x8*)(qpark + (4 + ks) * 1024);
#pragma unroll
                for (int kb = 0; kb < 2; ++kb) {
                    const bf16x8 k0 = *(const LAS bf16x8*)(Ks + 8192 * kb + ((ks & 1) ? kad1 : kad0) + 512 * (ks >> 1));
                    const bf16x8 k1 = *(const LAS bf16x8*)(Ks + 8192 * kb + ((ks & 1) ? kad1 : kad0) + 512 * (2 + (ks >> 1)));
                    S[kb][0] = MFMA32(k0, q0, S[kb][0]); S[kb][1] = MFMA32(k1, q1, S[kb][1]);
                    __builtin_amdgcn_sched_barrier(0);
                }
                __builtin_amdgcn_sched_barrier(0);
            }
            bf16x8 pf[2][2][2];
#pragma unroll
            for (int kb = 0; kb < 2; ++kb)
#pragma unroll
                for (int mm = 0; mm < 2; ++mm) { float lacc = 0.f;
#pragma unroll
                    for (int i = 0; i < 16; ++i) { S[kb][mm][i] = __builtin_amdgcn_exp2f(S[kb][mm][i]); lacc += S[kb][mm][i]; }
                    if (mm == 0) ls0 += lacc; else ls1 += lacc;
                    pf[kb][mm][0] = pack8(S[kb][mm], 0); pf[kb][mm][1] = pack8(S[kb][mm], 1);
                    __builtin_amdgcn_sched_barrier(0); }
            __builtin_amdgcn_sched_barrier(0);
#pragma unroll
            for (int kb = 0; kb < 2; ++kb)
#pragma unroll
                for (int s = 0; s < 2; ++s)
#pragma unroll
                    for (int d = 0; d < 4; ++d) {
                        const s16x4 lo = vtr(Vs + 8192 * kb + vad0 + 4096 * s + 512 * d);
                        const s16x4 hi = vtr(Vs + 8192 * kb + vad1 + 4096 * s + 512 * d);
                        const bf16x8 vf = __builtin_shufflevector(lo, hi, 0, 1, 2, 3, 4, 5, 6, 7);
                        O[0][d] = MFMA32(pf[kb][0][s], vf, O[0][d]); O[1][d] = MFMA32(pf[kb][1][s], vf, O[1][d]);
                        __builtin_amdgcn_sched_barrier(0);
                    }
        }
        VM_WAIT();
        __syncthreads();
    }
#undef AT_DMA
#undef kad1
#undef vad1
#undef AT_G16
    ls0 += __shfl_xor(ls0, 32); ls1 += __shfl_xor(ls1, 32);
    LAS float* lsc = (LAS float*)(lds + AT3_QS) + wave * 2048;
    if (hh == 0) { lsc[r] = 1.0f / ls0; lsc[32 + r] = lam / ls1; }
    LDS_WAIT(); asm volatile("" ::: "memory");
    float sg[4];
#pragma unroll
    for (int d = 0; d < 4; ++d) sg[d] = sub_gain[32 * d + r] * 0.8f;
#pragma unroll
    for (int i = 0; i < 16; ++i) {
        const int q = (i & 3) + 8 * (i >> 2) + 4 * hh; const float a0 = lsc[q], a1 = lsc[32 + q];
        float o[4]; float ss = 0.f;
#pragma unroll
        for (int d = 0; d < 4; ++d) { o[d] = O[0][d][i] * a0 - O[1][d][i] * a1; ss += o[d] * o[d]; }
#define AT_DPPF(v_, ctrl_) __builtin_bit_cast(float, __builtin_amdgcn_update_dpp(0, __builtin_bit_cast(int, (float)(v_)), ctrl_, 0xf, 0xf, true))
        ss += AT_DPPF(ss, 0xB1); ss += AT_DPPF(ss, 0x4E); ss += AT_DPPF(ss, 0x141); ss += AT_DPPF(ss, 0x140); ss += __shfl_xor(ss, 16);
#undef AT_DPPF
        const float rstd = __builtin_amdgcn_rsqf(ss * (1.f / 128.f) + RMS_EPS);
        bf16* orow = OAB + (rowb + q0w + q) * 2048 + h * 128 + r;
#pragma unroll
        for (int d = 0; d < 4; ++d) orow[32 * d] = (bf16)f2bf(o[d] * rstd * sg[d]);
        __builtin_amdgcn_sched_barrier(0);
    }
    __syncthreads();
}

constexpr int AT4_QS = 98304;
DEV void attn_unit4(LAS unsigned char* lds, int b, int h, int qblk, const bf16* Qb, const bf16* Kb, const bf16* Vb, int vpitch, bf16* OAB,
                   const float* table, const float* sub_gain, float lam, float shift, int tid, int lane, int wave) {
    asm volatile("" : "+v"(lane), "+v"(tid));
    const int r = lane & 31, hh = lane >> 5;
    const int q0w = 256 * qblk + 32 * wave;
    const int cq = q0w >> 6;
    const int ntile = 4 * qblk + 4;
    const size_t rowb = (size_t)b * SEQ;
    LAS float* lut = (LAS float*)(lds + AT3_LUT);
    for (int i = tid; i < 320; i += NTHR) lut[i] = table[t5_bucket(i - 255) * 8 + h] * LOG2E - shift;
    bf16x8 qf[4];
    LAS unsigned char* qpark = lds + AT4_QS + wave * 4096 + lane * 16;
    { const bf16* qrow = Qb + (rowb + q0w + r) * (size_t)vpitch + h * 128 + 8 * hh;
#pragma unroll
      for (int ks = 0; ks < 4; ++ks) { qf[ks] = *(const bf16x8*)(qrow + 16 * ks); *(LAS bf16x8*)(qpark + ks * 1024) = *(const bf16x8*)(qrow + 64 + 16 * ks); } }
    const int srow = 8 * wave + ((lane & 31) >> 2), sch = 4 * (lane >> 5) + ((lane & 3) ^ ((srow >> 2) & 3));
    const unsigned goff = (unsigned)(((size_t)srow * vpitch + h * 128 + sch * 8) * 2);
    const unsigned long long kbase = (unsigned long long)(Kb + rowb * (size_t)vpitch), vbase = (unsigned long long)(Vb + rowb * (size_t)vpitch);
    const int sdst = 2048 * wave;
#define AT_G16(sbase, ldsoff) do { unsigned keep_; asm volatile("s_mov_b32 %0, m0\n\ts_mov_b32 m0, %2\n\ts_nop 0\n\tglobal_load_lds_dwordx4 %1, %3\n\ts_mov_b32 m0, %4\n\ts_nop 0\n\tglobal_load_lds_dwordx4 %1, %5\n\ts_mov_b32 m0, %0" \
        : "=&s"(keep_) : "v"(goff), "s"(ldsoff), "s"(sbase), "s"((ldsoff) + 1024u), "s"((sbase) + 128ull) : "memory"); } while (0)
#define AT_DMA(j, buf) do { const unsigned sb_ = (unsigned)__builtin_amdgcn_readfirstlane((int)(unsigned)(unsigned long)(lds + ((j) % 3) * AT_STAGE + sdst)); \
        const unsigned long long tb_ = (unsigned long long)(j) * 64ull * (unsigned long long)vpitch * 2ull; \
        AT_G16(kbase + tb_, sb_); AT_G16(vbase + tb_, sb_ + 16384u); } while (0)
    AT_DMA(0, 0); if (ntile > 1) AT_DMA(1, 1);
    VM_WAIT();
#pragma unroll
    for (int ks = 0; ks < 4; ++ks) asm volatile("" : "+v"(qf[ks]));
    __syncthreads();
    f32x16 O[2][4];
#pragma unroll
    for (int mm = 0; mm < 2; ++mm)
#pragma unroll
        for (int d = 0; d < 4; ++d)
#pragma unroll
            for (int i = 0; i < 16; ++i) O[mm][d][i] = 0.f;
    float ls0 = 0.f, ls1 = 0.f;
    unsigned kad0, vad0;
    { const int blk = (lane >> 4) & 1, tq = (lane & 15) >> 2, tp = lane & 3;
      kad0 = off_a(r, hh);
      vad0 = off_a(4 * hh + tq, 2 * blk + (tp >> 1)) + 8 * (tp & 1); }
#define kad1 (kad0 ^ 32u)
#define vad1 ((vad0 ^ 32u) + 2048u)
    for (int j = 0; j < ntile; ++j) {
        const bool more2 = (j + 2 < ntile);
        if (more2) AT_DMA(j + 2, 0);
        if (j <= cq) {
            const LAS unsigned char* Ks = lds + (j % 3) * AT_STAGE; const LAS unsigned char* Vs = Ks + 16384;
            const bool nearb = (j + 2 >= cq);
#pragma unroll 1
            for (int kb = 0; kb < 2; ++kb) {
                f32x16 s0, s1;
                if (nearb) { const int base = 64 * j + 32 * kb + 4 * hh - q0w - r + 255;
#pragma unroll
                    for (int i = 0; i < 16; ++i) { const float bv = lut[base + (i & 3) + 8 * (i >> 2)]; s0[i] = bv; s1[i] = bv; } }
                else { const float cfar = lut[0];
#pragma unroll
                    for (int i = 0; i < 16; ++i) { s0[i] = cfar; s1[i] = cfar; } }
#pragma unroll
                for (int ks = 0; ks < 4; ++ks) {
                    const bf16x8 k0 = *(const LAS bf16x8*)(Ks + 8192 * kb + ((ks & 1) ? kad1 : kad0) + 512 * (ks >> 1));
                    s0 = MFMA32(k0, qf[ks], s0);
                }
                __builtin_amdgcn_sched_barrier(0);
#pragma unroll
                for (int ks = 0; ks < 4; ++ks) {
                    const bf16x8 k1 = *(const LAS bf16x8*)(Ks + 8192 * kb + ((ks & 1) ? kad1 : kad0) + 512 * (2 + (ks >> 1)));
                    s1 = MFMA32(k1, *(const LAS bf16x8*)(qpark + ks * 1024), s1);
#pragma unroll
                    for (int i = 4 * ks; i < 4 * ks + 4; ++i) { s0[i] = __builtin_amdgcn_exp2f(s0[i]); ls0 += s0[i]; }
                    __builtin_amdgcn_sched_barrier(0);
                }
                bf16x8 pf[2][2];
                pf[0][0] = pack8(s0, 0); pf[0][1] = pack8(s0, 1);
#pragma unroll
                for (int i = 0; i < 16; ++i) { s1[i] = __builtin_amdgcn_exp2f(s1[i]); ls1 += s1[i]; }
                pf[1][0] = pack8(s1, 0); pf[1][1] = pack8(s1, 1);
                __builtin_amdgcn_sched_barrier(0);
#pragma unroll
                for (int s = 0; s < 2; ++s)
#pragma unroll
                    for (int d = 0; d < 4; ++d) {
                        const s16x4 lo = vtr(Vs + 8192 * kb + vad0 + 4096 * s + 512 * d);
                        const s16x4 hi = vtr(Vs + 8192 * kb + vad1 + 4096 * s + 512 * d);
                        const bf16x8 vf = __builtin_shufflevector(lo, hi, 0, 1, 2, 3, 4, 5, 6, 7);
                        O[0][d] = MFMA32(pf[0][s], vf, O[0][d]); O[1][d] = MFMA32(pf[1][s], vf, O[1][d]);
                        if (d & 1) __builtin_amdgcn_sched_barrier(0);
                    }
            }
        }
        if (more2) asm volatile("s_waitcnt vmcnt(4)" ::: "memory"); else VM_WAIT();
        __syncthreads();
    }
#undef AT_DMA
#undef kad1
#undef vad1
#undef AT_G16
    ls0 += __shfl_xor(ls0, 32); ls1 += __shfl_xor(ls1, 32);
    LAS float* lsc = (LAS float*)(lds + AT4_QS) + wave * 1024;
    if (hh == 0) { lsc[r] = 1.0f / ls0; lsc[32 + r] = lam / ls1; }
    LDS_WAIT(); asm volatile("" ::: "memory");
    float sg[4];
#pragma unroll
    for (int d = 0; d < 4; ++d) sg[d] = sub_gain[32 * d + r] * 0.8f;
#pragma unroll
    for (int i = 0; i < 16; ++i) {
        const int q = (i & 3) + 8 * (i >> 2) + 4 * hh; const float a0 = lsc[q], a1 = lsc[32 + q];
        float o[4]; float ss = 0.f;
#pragma unroll
        for (int d = 0; d < 4; ++d) { o[d] = O[0][d][i] * a0 - O[1][d][i] * a1; ss += o[d] * o[d]; }
#define AT_DPPF(v_, ctrl_) __builtin_bit_cast(float, __builtin_amdgcn_update_dpp(0, __builtin_bit_cast(int, (float)(v_)), ctrl_, 0xf, 0xf, true))
        ss += AT_DPPF(ss, 0xB1); ss += AT_DPPF(ss, 0x4E); ss += AT_DPPF(ss, 0x141); ss += AT_DPPF(ss, 0x140); ss += __shfl_xor(ss, 16);
#undef AT_DPPF
        const float rstd = __builtin_amdgcn_rsqf(ss * (1.f / 128.f) + RMS_EPS);
        bf16* orow = OAB + (rowb + q0w + q) * 2048 + h * 128 + r;
#pragma unroll
        for (int d = 0; d < 4; ++d) orow[32 * d] = (bf16)f2bf(o[d] * rstd * sg[d]);
        __builtin_amdgcn_sched_barrier(0);
    }
    __syncthreads();
}


constexpr int LR_WT = 0, LR_X = 65536, LR_XP = 272, LR_CONST = 101376, LR_SUM = 105984, LR_PRE = 110080, LR_END = 115200;
static_assert(LR_END <= LDSCTL_OFF, "LRU LDS map");
DEV void lru_xload(v4u (&xw_)[5], const bf16* PROJ, int b, int g, int tc, int tid) {
    const size_t grow0 = (size_t)b * SEQ + 128 * tc;
#pragma unroll
    for (int k = 0; k < 5; ++k) { const int c = tid + NTHR * k, rho = c >> 4, ch = c & 15; xw_[k] = (v4u){0u, 0u, 0u, 0u};
        if (c < 131 * 16 && (tc > 0 || rho >= 3)) xw_[k] = *(const v4u*)(PROJ + (grow0 + rho - 3) * P5P + C_XL + g * 128 + ch * 8); }
}
DEV void lru_unit(LAS unsigned char* lds, int b, int g, int tc, const bf16* PROJ, const bf16* WL, const float* cw, const float* cb, const float* ba, const float* bxv, const float* lamp,
                  bf16* HL, bf16* PL, float* SP, float* SH, bool load_w, int tid, int lane, int wave, v4u (&xw_)[5], int nb, int ng, int ntc, bool has_next) {
    asm volatile("" : "+v"(lane), "+v"(tid));
    const int r = lane & 31, hh = lane >> 5, tb = wave & 3, chh = wave >> 2;
    const unsigned wad0 = off_a(r, hh), wad1 = off_a(r, 2 + hh);
    LAS float* cst = (LAS float*)(lds + LR_CONST);
    if (load_w) {
#pragma unroll
        for (int gate = 0; gate < 2; ++gate)
            for (int c = tid; c < 2048; c += NTHR) { const int row = c >> 4, ch = c & 15;
                const v4u w = *(const v4u*)(WL + ((size_t)((gate * 8 + g) * 128 + row)) * 128 + ch * 8); *(LAS v4u*)(lds + LR_WT + gate * 32768 + off_a(row, ch)) = w; }
        if (tid < 128) { const int gc = g * 128 + tid;
#pragma unroll
            for (int tap = 0; tap < 4; ++tap) cst[tap * 128 + tid] = cw[tap * 1024 + gc];
            cst[512 + tid] = cb[gc]; cst[640 + tid] = ba[gc]; cst[768 + tid] = bxv[gc];
            const float z = -lamp[gc]; const float sp = fmaxf(z, 0.f) + log1pf(__expf(-fabsf(z))); cst[896 + tid] = -8.0f * sp * LOG2E; }
    }
    const size_t grow0 = (size_t)b * SEQ + 128 * tc;
    {
#pragma unroll
      for (int k = 0; k < 5; ++k) { const int c = tid + NTHR * k, rho = c >> 4, ch = c & 15; if (c < 131 * 16) *(LAS v4u*)(lds + LR_X + rho * LR_XP + ch * 16) = xw_[k]; } }
    if (has_next) lru_xload(xw_, PROJ, nb, ng, ntc, tid);
    __syncthreads();
    const int tl = 32 * tb + r;
    bf16x8 xrf[8];
#pragma unroll
    for (int ks = 0; ks < 8; ++ks) {
        float v[8];
#pragma unroll
        for (int q = 0; q < 2; ++q) { const int cbase = 16 * ks + 8 * q + 4 * hh; f32x4 a = *(const LAS f32x4*)(cst + 512 + cbase);
#pragma unroll
            for (int tap = 0; tap < 4; ++tap) { const v2u xw = *(const LAS v2u*)(lds + LR_X + (tl + tap) * LR_XP + cbase * 2); const f32x4 w = *(const LAS f32x4*)(cst + tap * 128 + cbase);
                a.x += w.x * bf2f(xw.x & 0xffffu); a.y += w.y * bf2f(xw.x >> 16); a.z += w.z * bf2f(xw.y & 0xffffu); a.w += w.w * bf2f(xw.y >> 16); }
            v[4 * q] = a.x; v[4 * q + 1] = a.y; v[4 * q + 2] = a.z; v[4 * q + 3] = a.w; }
        v4u p; p.x = cvtpk_s(v[0], v[1]); p.y = cvtpk_s(v[2], v[3]); p.z = cvtpk_s(v[4], v[5]); p.w = cvtpk_s(v[6], v[7]);
        xrf[ks] = __builtin_bit_cast(bf16x8, p);
        __builtin_amdgcn_sched_barrier(0);
    }
    f32x16 acc[2][2];
    const LAS unsigned char* wbase = lds + LR_WT + 16384 * chh;
#pragma unroll
    for (int gate = 0; gate < 2; ++gate)
#pragma unroll
        for (int c2 = 0; c2 < 2; ++c2) {
#pragma unroll
            for (int i = 0; i < 16; ++i) acc[gate][c2][i] = 0.f;
#pragma unroll
            for (int ks = 0; ks < 8; ++ks) { const bf16x8 af = *(const LAS bf16x8*)(wbase + gate * 32768 + 8192 * c2 + 512 * (ks >> 1) + ((ks & 1) ? wad1 : wad0)); acc[gate][c2] = MFMA32(af, xrf[ks], acc[gate][c2]); }
            __builtin_amdgcn_sched_barrier(0);
        }
    const LAS float* cstw = cst + 64 * chh;
#pragma unroll
    for (int c2 = 0; c2 < 2; ++c2)
#pragma unroll
        for (int idx = 0; idx < 16; ++idx) {
            const int cl = 32 * c2 + (idx & 3) + 8 * (idx >> 2) + 4 * hh;
            const float rg = __builtin_amdgcn_rcpf(1.0f + __expf(-(acc[0][c2][idx] + cstw[640 + cl]))), ig = __builtin_amdgcn_rcpf(1.0f + __expf(-(acc[1][c2][idx] + cstw[768 + cl])));
            const float la2 = rg * cstw[896 + cl]; float a = __builtin_amdgcn_exp2f(la2); const float mult = __builtin_amdgcn_sqrtf(fmaxf(1.0f - __builtin_amdgcn_exp2f(2.0f * la2), 0.f));
            const int e = 4 * ((idx >> 2) & 1) + (idx & 3), k4 = 2 * c2 + (idx >> 3);
            const unsigned short xs = chh ? (unsigned short)xrf[4 + k4][e] : (unsigned short)xrf[k4][e];
            float hv = mult * ig * bf2f((unsigned)xs);
#define LR_DPP(oldv_, srcv_, ctrl_, rmask_) __builtin_bit_cast(float, __builtin_amdgcn_update_dpp(__builtin_bit_cast(int, (float)(oldv_)), __builtin_bit_cast(int, (float)(srcv_)), ctrl_, rmask_, 0xf, false))
#define LR_STEP(ctrl_, rmask_) do { const float ap_ = LR_DPP(1.0f, a, ctrl_, rmask_), hp_ = LR_DPP(0.0f, hv, ctrl_, rmask_); hv = a * hp_ + hv; a = a * ap_; } while (0)
            LR_STEP(0x111, 0xf); LR_STEP(0x112, 0xf); LR_STEP(0x114, 0xf); LR_STEP(0x118, 0xf); LR_STEP(0x142, 0xa);
#undef LR_STEP
#undef LR_DPP
            acc[0][c2][idx] = a; acc[1][c2][idx] = hv;
            if (idx & 1) __builtin_amdgcn_sched_barrier(0);
        }
    LAS float* sumP = (LAS float*)(lds + LR_SUM); LAS float* sumH = sumP + 512;
    if (r == 31) {
#pragma unroll
        for (int c2 = 0; c2 < 2; ++c2)
#pragma unroll
            for (int idx = 0; idx < 16; ++idx) { const int cl = 64 * chh + 32 * c2 + (idx & 3) + 8 * (idx >> 2) + 4 * hh; sumP[tb * 128 + cl] = acc[0][c2][idx]; sumH[tb * 128 + cl] = acc[1][c2][idx]; }
    }
    __syncthreads();
    LAS float* preP = (LAS float*)(lds + LR_PRE); LAS float* preH = preP + 640;
    if (tid < 128) { float Pc = 1.0f, Hc = 0.f;
        for (int w = 0; w < 4; ++w) { preP[w * 128 + tid] = Pc; preH[w * 128 + tid] = Hc; const float sp_ = sumP[w * 128 + tid]; Hc = sp_ * Hc + sumH[w * 128 + tid]; Pc *= sp_; }
        SP[(size_t)(b * 32 + tc) * 1024 + g * 128 + tid] = Pc; SH[(size_t)(b * 32 + tc) * 1024 + g * 128 + tid] = Hc; }
    __syncthreads();
    bf16* hrow = HL + (grow0 + tl) * 1024 + g * 128 + 64 * chh; bf16* prow = PL + (grow0 + tl) * 1024 + g * 128 + 64 * chh;
#pragma unroll
    for (int c2 = 0; c2 < 2; ++c2)
#pragma unroll
        for (int ip = 0; ip < 2; ++ip) { v2u hw[2], pw[2];
#pragma unroll
            for (int s2 = 0; s2 < 2; ++s2) { const int i4 = 2 * ip + s2, cl0 = 32 * c2 + 8 * i4 + 4 * hh; const f32x4 pp = *(const LAS f32x4*)(preP + tb * 128 + 64 * chh + cl0), ph = *(const LAS f32x4*)(preH + tb * 128 + 64 * chh + cl0);
                const float P0 = acc[0][c2][4 * i4], P1 = acc[0][c2][4 * i4 + 1], P2 = acc[0][c2][4 * i4 + 2], P3 = acc[0][c2][4 * i4 + 3];
                hw[s2].x = cvtpk_s(acc[1][c2][4 * i4] + P0 * ph.x, acc[1][c2][4 * i4 + 1] + P1 * ph.y); hw[s2].y = cvtpk_s(acc[1][c2][4 * i4 + 2] + P2 * ph.z, acc[1][c2][4 * i4 + 3] + P3 * ph.w);
                pw[s2].x = cvtpk_s(P0 * pp.x, P1 * pp.y); pw[s2].y = cvtpk_s(P2 * pp.z, P3 * pp.w); }
            { auto r0 = __builtin_amdgcn_permlane32_swap(hw[0].x, hw[1].x, false, false); auto r1 = __builtin_amdgcn_permlane32_swap(hw[0].y, hw[1].y, false, false);
              auto r2 = __builtin_amdgcn_permlane32_swap(pw[0].x, pw[1].x, false, false); auto r3 = __builtin_amdgcn_permlane32_swap(pw[0].y, pw[1].y, false, false);
              const int co = 32 * c2 + 16 * ip + 8 * hh;
              *(v4u*)(hrow + co) = (v4u){(unsigned)r0[0], (unsigned)r1[0], (unsigned)r0[1], (unsigned)r1[1]}; *(v4u*)(prow + co) = (v4u){(unsigned)r2[0], (unsigned)r3[0], (unsigned)r2[1], (unsigned)r3[1]}; } }
    __syncthreads();
}

struct Args { const float* in[29]; float* out; unsigned char* ws; int ph_lo, ph_hi; };
constexpr int NPHASE = 15;

DEV void moe_tiles(const unsigned* cnt_g, LAS unsigned char* lds, int tid) {
    LAS int* texp = (LAS int*)(lds + TEXP_OFF); LAS int* pads = (LAS int*)(lds + PADS_OFF); LAS int* cl = (LAS int*)(lds + CNTL_OFF); LAS int* nmt = (LAS int*)(lds + NMT_OFF); LAS int* arow = (LAS int*)(lds + AROW_OFF);
    __syncthreads();
    if (tid < 32) cl[tid] = (int)__hip_atomic_load(cnt_g + 64 * tid, RLX_AGENT);
    __syncthreads();
    if (tid == 0) {
        int nt = 0;
        for (int e = 0; e < NE; ++e) { const int c = cl[e]; const int ntile = (c + 255) >> 8; pads[e] = nt * 256; for (int i = 0; i < ntile; ++i) { texp[nt + i] = e; arow[nt + i] = e * T + 256 * i; } nt += ntile; }
        pads[NE] = nt * 256; nmt[0] = nt;
    }
    __syncthreads();
}

__global__ void __launch_bounds__(NTHR, 2) fwd_kernel(Args args) {
    extern __shared__ __attribute__((aligned(16))) unsigned char lds_raw[];
    LAS unsigned char* lds = (LAS unsigned char*)lds_raw;
    const int tid = threadIdx.x, lane = tid & 63, wave = __builtin_amdgcn_readfirstlane(tid >> 6);
    const int G = gridDim.x, bx = blockIdx.x;
    const int gw = bx * NWAVES + wave, NGW = G * NWAVES;
    const int gt = bx * NTHR + tid, NGT = G * NTHR;
    gu32* ctl = (gu32*)(args.ws + WS_CTL);
    for (int u = tid; u < (LDS_BYTES - LDSCTL_OFF) / 4; u += NTHR) ((LAS unsigned*)(lds + LDSCTL_OFF))[u] = 0u;
    __syncthreads();
    XcdBarrier bar = xcd_barrier_post((unsigned*)ctl + CW_BAR, (volatile LAS unsigned*)(lds + MISC_OFF));
    const int lo = args.ph_lo, hi = args.ph_hi;
#ifndef PHMASK
#define PHMASK 0x7fff
#endif
#define IN(k) ((((PHMASK) >> (k)) & 1) && lo <= (k) && (k) < hi)
#define SEAM(k) do { if (IN(k) && IN((k) + 1)) xcd_barrier(bar); } while (0)

    typedef const __attribute__((address_space(4))) Args* KArgs;
#define PH_PTRS KArgs ka = (KArgs)__builtin_amdgcn_kernarg_segment_ptr(); asm volatile("" : "+s"(ka)); unsigned char* ws = ka->ws; const float* x = ka->in[0]; bf16* WIN_T = (bf16*)(ws + WS_WIN); bf16* WA_T = (bf16*)(ws + WS_WA); bf16* WB_T = (bf16*)(ws + WS_WB); bf16* WOUT_T = (bf16*)(ws + WS_WOUT); bf16* W1_T = (bf16*)(ws + WS_W1); bf16* W2_T = (bf16*)(ws + WS_W2); bf16* Hb = (bf16*)(ws + WS_H); bf16* H8 = (bf16*)(ws + WS_XG);        bf16* PROJ = (bf16*)(ws + WS_PROJ); bf16* GT = (bf16*)(ws + WS_PROJ + 160 * MiB); bf16* Qb = (bf16*)(ws + WS_Q); bf16* Kb = (bf16*)(ws + WS_K); bf16* OAB = (bf16*)(ws + WS_OAB); bf16* HL = (bf16*)(ws + WS_LA); bf16* PL = (bf16*)(ws + WS_LA + 32 * MiB); float* SPs = (float*)(ws + WS_LU); float* SHs = (float*)(ws + WS_LU + 1 * MiB); bf16* WL = (bf16*)(ws + WS_WL); float* RSTD = (float*)(ws + WS_WL + 512 * 1024); float* RSS = (float*)(ws + WS_RSS); unsigned char* XGS = ws + WS_XGS; bf16* YA = (bf16*)(ws + WS_YA); bf16* YB = (bf16*)(ws + WS_YB); bf16* MIX = (bf16*)(ws + WS_MIX); bf16* H2 = (bf16*)(ws + WS_H2); bf16* XG = (bf16*)(ws + WS_XG); bf16* ACT = (bf16*)(ws + WS_ACT); bf16* EO = (bf16*)(ws + WS_EO); int* route_e = (int*)(ws + WS_ROUTE); int* route_rank = route_e + T * TOPK; float* route_gate = (float*)(route_rank + T * TOPK); int* tok_by_e = (int*)(route_gate + T * TOPK); unsigned* cnt_g = (unsigned*)ctl + CW_CNT; float* out = ka->out;

    constexpr int I_1 = (D / 128) * (HID / 64), I_2 = (FF / 128) * (D / 64);
#define CONV_W1() do { for (int it_ = gw; it_ < NE * I_1; it_ += NGW) { const int e_ = it_ / I_1; p0_tr8_item(ka->in[25] + (size_t)e_ * D * HID, D, HID, (unsigned char*)W1_T + (size_t)e_ * HID * D, it_ % I_1, lane, 512.0f); } } while (0)
#define CONV_W2() do { for (int it_ = gw; it_ < NE * I_2; it_ += NGW) { const int e_ = it_ / I_2; p0_tr8_item(ka->in[27] + (size_t)e_ * FF * D, FF, D, (unsigned char*)W2_T + (size_t)e_ * D * FF, it_ % I_2, lane, 512.0f); } } while (0)
    const bool conv_first = ((bx >> 3) & 1) != 0;

    if (IN(0)) { PH_PTRS;
        LAS float* scr = (LAS float*)(lds + RING_OFF + wave * 16384);
        constexpr int I_IN = 0, I_IN8 = (D / 128) * (INC / 64), I_A = (AW / 128) * (D / 64), I_O = (D / 128) * (D / 64);
        constexpr int NITEMS = I_IN + I_IN8;
        for (int it = gw; it < NITEMS; it += NGW) {
            int r = it;
            if (r < I_IN8) { p0_tr8_item(ka->in[2], D, INC, (unsigned char*)WIN_T, r, lane, 512.0f, INC, true); continue; } r -= I_IN8;
        }
        for (int idx = gt; idx < 2 * 8 * 128 * 128; idx += NGT) {
            const int gate = idx >> 17, gg = (idx >> 14) & 7, j = (idx >> 7) & 127, p = idx & 127, ks = p >> 4, pp = p & 15, i = 16 * ks + 8 * ((pp >> 2) & 1) + 4 * (pp >> 3) + (pp & 3);
            WL[idx] = (bf16)f2bf((gate ? ka->in[16] : ka->in[14])[(size_t)(gg * 128 + i) * 128 + j]); }
#pragma unroll 4
        for (int m = gw; m < T; m += NGW) rms_row_to_bf16(x + (size_t)m * D, ka->in[1], nullptr, (unsigned char*)H8 + (size_t)m * D, lane);
    }
    SEAM(0);
    if (IN(1)) { PH_PTRS;
        { pg8::Gemm g{H8, WIN_T, T, INC, D, D, D}; pg8::ConvOrder<D, HID, 2, 3> S; S.init(T, INC, G, bx); S.wsrc = &ka->in[25]; S.wsp = &ka->ws; S.wsoff = WS_W1; S.ub = 0 - ((bx >> 3) & 3); S.ucount = 0;
          pg8::EpiProj E{PROJ, GT, ka->in[4], ka->in[5], ka->in[3], 0, 1.0f / 8192.0f};
          pg8::gemm_phase<pg8::EpiProj, pg8::ConvOrder<D, HID, 2, 3>, true, true, 1>(lds + RING_OFF, g, S, E); }
        for (int it_ = gw + 16 * NGW; it_ < NE * I_1; it_ += NGW) { const int e_ = it_ / I_1; p0_tr8_item_h(ka->in[25] + (size_t)e_ * D * HID, D, HID, (unsigned char*)W1_T + (size_t)e_ * HID * D, it_ % I_1, lane, 512.0f); }
    }
    SEAM(1);
    if (IN(3)) { PH_PTRS;
        float lam, shift;
        { const float a = wave_sum(ka->in[6][lane] * ka->in[7][lane]), b2_ = wave_sum(ka->in[8][lane] * ka->in[9][lane]); lam = __expf(a) - __expf(b2_) + 0.2f;
          const float gq = wave_max(fabsf(ka->in[4][lane])), gk = wave_max(fabsf(ka->in[5][lane]));
          const float* tb = ka->in[11]; const float mb = wave_max(fmaxf(fmaxf(fabsf(tb[lane]), fabsf(tb[64 + lane])), fmaxf(fabsf(tb[128 + lane]), fabsf(tb[192 + lane]))));
          shift = 11.5415603f * gq * gk + mb * LOG2E; }
        lam = __builtin_bit_cast(float, __builtin_amdgcn_readfirstlane(__builtin_bit_cast(int, lam))); shift = __builtin_bit_cast(float, __builtin_amdgcn_readfirstlane(__builtin_bit_cast(int, shift)));
        const int cls3 = (bx >> 3) & 3; int au = 0;
#define CONV_W1_S2() do { { constexpr int IA_ = (AW / 128) * (D / 64), IO_ = (D / 128) * (D / 64); const int r_ = gw; if (r_ < 2 * IA_ + IO_) { const int sel_ = r_ < IA_ ? 0 : r_ < 2 * IA_ ? 1 : 2; const float* w_ = ka->in[19 + sel_]; bf16* d_ = sel_ == 0 ? WA_T : sel_ == 1 ? WB_T : WOUT_T; p0_tr16_item_h(w_, sel_ == 2 ? D : AW, D, d_, r_ - (sel_ == 0 ? 0 : sel_ == 1 ? IA_ : 2 * IA_), lane, D); } } \
        for (int k_ = 6; k_ < 16; ++k_) { const int it_ = gw + k_ * NGW; if (it_ < NE * I_1) { const int e_ = it_ / I_1; p0_tr8_item_h(ka->in[25] + (size_t)e_ * D * HID, D, HID, (unsigned char*)W1_T + (size_t)e_ * HID * D, it_ % I_1, lane, 512.0f); } } } while (0)
        if (cls3 == 0) CONV_W1_S2();
        for (int u = bx; u < 512; u += G, ++au) {
            if (au == 1 && cls3 == 1) CONV_W1_S2();
            const int v = u & 255, bh = v >> 3, qblk = (u < 256) ? (v & 7) : 15 - (v & 7);
            attn_unit4(lds + RING_OFF, bh >> 3, bh & 7, qblk, PROJ + C_Q, PROJ + C_K, PROJ + C_V, P5P, OAB, ka->in[11], ka->in[10], lam, shift, tid, lane, wave);
        }
    }
    if (IN(3)) { PH_PTRS; const int cls3 = (bx >> 3) & 3; if (cls3 >= 2 && cls3 == 2) CONV_W1_S2(); }
    if (IN(4)) { PH_PTRS;
        int i = 0; v4u xw_[5];
        if (bx < 1024) lru_xload(xw_, PROJ, (bx >> 3) >> 5, bx & 7, (bx >> 3) & 31, tid);
        for (int u = bx; u < 1024; u += G, ++i) {
            const int g = u & 7, bt = u >> 3, nu = u + G, nbt = nu >> 3;
            lru_unit(lds, bt >> 5, g, bt & 31, PROJ, WL, ka->in[12], ka->in[13], ka->in[15], ka->in[17], ka->in[18], HL, PL, SPs, SHs, (i == 0) || (G & 7) != 0, tid, lane, wave, xw_, nbt >> 5, nu & 7, nbt & 31, nu < 1024);
        }
        if (((bx >> 3) & 3) == 3) CONV_W1_S2();
    }
    SEAM(4);
    if (IN(5)) { PH_PTRS;
        LAS float* partP = (LAS float*)(lds + RING_OFF); LAS float* partH = partP + 4096;
        for (int u = bx; u < 256; u += G) {
            const int b = u >> 6, tc = (u >> 1) & 31, hf = u & 1, c8 = (tid & 127) * 8, rg = tid >> 7;
            float pP[8], pH[8];
#pragma unroll
            for (int j = 0; j < 8; ++j) { pP[j] = 1.0f; pH[j] = 0.0f; }
#pragma unroll 1
            for (int t0 = 8 * rg; t0 < min(8 * rg + 8, tc); t0 += 4) {
                f32x4 sp[4][2], sh[4][2];
#pragma unroll
                for (int k = 0; k < 4; ++k) { const int t2 = min(t0 + k, tc - 1); const float* spp = SPs + (size_t)(b * 32 + t2) * 1024 + c8; const float* shp = SHs + (size_t)(b * 32 + t2) * 1024 + c8;
                    sp[k][0] = *(const f32x4*)spp; sp[k][1] = *(const f32x4*)(spp + 4); sh[k][0] = *(const f32x4*)shp; sh[k][1] = *(const f32x4*)(shp + 4); }
#pragma unroll
                for (int k = 0; k < 4; ++k) if (t0 + k < min(8 * rg + 8, tc)) {
#pragma unroll
                    for (int j = 0; j < 8; ++j) { const float a = sp[k][j >> 2][j & 3]; pH[j] = a * pH[j] + sh[k][j >> 2][j & 3]; pP[j] = a * pP[j]; } }
            }
            __syncthreads();
#pragma unroll
            for (int j = 0; j < 8; j += 4) { *(LAS f32x4*)(partP + rg * 1024 + c8 + j) = (f32x4){pP[j], pP[j + 1], pP[j + 2], pP[j + 3]}; *(LAS f32x4*)(partH + rg * 1024 + c8 + j) = (f32x4){pH[j], pH[j + 1], pH[j + 2], pH[j + 3]}; }
            __syncthreads();
            float hc[8];
#pragma unroll
            for (int j = 0; j < 8; ++j) hc[j] = 0.0f;
#pragma unroll
            for (int k = 0; k < 4; ++k)
#pragma unroll
                for (int j = 0; j < 8; j += 4) { const f32x4 P4 = *(const LAS f32x4*)(partP + k * 1024 + c8 + j), H4 = *(const LAS f32x4*)(partH + k * 1024 + c8 + j);
                    hc[j] = P4.x * hc[j] + H4.x; hc[j + 1] = P4.y * hc[j + 1] + H4.y; hc[j + 2] = P4.z * hc[j + 2] + H4.z; hc[j + 3] = P4.w * hc[j + 3] + H4.w; }
#pragma unroll 4
            for (int i = 0; i < 16; ++i) { const size_t t = (size_t)b * SEQ + 128 * tc + 64 * hf + rg + 4 * i;
                const v4u hw = *(const v4u*)(HL + t * 1024 + c8), pw = *(const v4u*)(PL + t * 1024 + c8), gl = *(const v4u*)(PROJ + t * P5P + C_GL + c8);
                v4u o;
#define FX2(hw_, pw_, gl_, j_) pk2((bf2f((hw_) & 0xffffu) + bf2f((pw_) & 0xffffu) * hc[j_]) * bf2f((gl_) & 0xffffu), (bf2f((hw_) >> 16) + bf2f((pw_) >> 16) * hc[(j_) + 1]) * bf2f((gl_) >> 16))
                o.x = FX2(hw.x, pw.x, gl.x, 0); o.y = FX2(hw.y, pw.y, gl.y, 2); o.z = FX2(hw.z, pw.z, gl.z, 4); o.w = FX2(hw.w, pw.w, gl.w, 6);
#undef FX2
                *(v4u*)(OAB + t * 2048 + 1024 + c8) = o; }
        }
        __syncthreads();
    }
    SEAM(6);
    if (IN(7)) { PH_PTRS;
        pg8::Gemm g{OAB, WA_T, T, D, AW, 2048, AW}; pg8::PairOrder S; S.init(T, D, G, bx); S.a1 = (size_t)1024 * 2; S.b1 = WS_WB - WS_WA;
        pg8::EpiMix2 E{MIX, (const unsigned char*)GT};
        pg8::gemm_phase<pg8::EpiMix2, pg8::PairOrder, true, true>(lds + RING_OFF, g, S, E);
    }
    SEAM(7);
    if (IN(9)) { PH_PTRS;
        pg8::Gemm g{MIX, WOUT_T, T, D, D, D, D}; pg8::StaticOrder S; S.init(T, D, G, bx);
        pg8::EpiBf16Res E{YB, x};
        pg8::gemm_phase<pg8::EpiBf16Res, pg8::StaticOrder, true, true>(lds + RING_OFF, g, S, E);
    }
    SEAM(9);
    if (IN(10)) { PH_PTRS;
        const float* lnf = ka->in[22]; const float* wr = ka->in[23]; const float* br = ka->in[24];
        LAS float* xs = (LAS float*)(lds + RING_OFF);
        LAS float* wsl = (LAS float*)(lds + RING_OFF + 66560);
        LAS float* rst = (LAS float*)(lds + RING_OFF + 99328);
        LAS unsigned* lcnt = (LAS unsigned*)(lds + RING_OFF + 99328 + 256); LAS unsigned* lbase = lcnt + 32; LAS unsigned* ent_a = lcnt + 64; LAS float* ent_g = (LAS float*)(ent_a + 512);
        const int e_ = lane & 31, dh = lane >> 5, tok_s = tid >> 3, seg = tid & 7;
        for (int pb = bx * 64; pb < T; pb += G * 64) {
            if (tid < 32) lcnt[tid] = 0u;
            f32x16 macc[2]; float ssq = 0.f;
#pragma unroll
            for (int i = 0; i < 16; ++i) { macc[0][i] = 0.f; macc[1][i] = 0.f; }
            const int r32 = lane & 31, hh = lane >> 5;
            v4u xwA[4], xwB[4]; f32x4 wv[4];
            const int row = tid >> 1, c0 = (tid & 1) * 16;
            LAS float* lnl = (LAS float*)(lds + RING_OFF + 106496);
            *(LAS f32x4*)(lnl + 4 * tid) = *(const GAS f32x4*)(lnf + 4 * tid);
#define RT_LOAD(S_, sl_) do { const GAS v4u* src_ = (const GAS v4u*)(YB + (size_t)(pb + tok_s) * D + 256 * (sl_) + 32 * seg); \
                _Pragma("unroll") for (int q = 0; q < 4; ++q) xw##S_[q] = src_[q]; } while (0)
#define RT_LOADW(sl_) do { const GAS f32x4* wsrc_ = (const GAS f32x4*)(wr + (size_t)(256 * (sl_) + row) * 32 + c0); _Pragma("unroll") for (int q = 0; q < 4; ++q) wv[q] = wsrc_[q]; } while (0)
#define RT_XV(S_, q_) (((q_) & 1) ? (f32x4){__uint_as_float(xw##S_[(q_) >> 1].z << 16), __uint_as_float(xw##S_[(q_) >> 1].z & 0xffff0000u), __uint_as_float(xw##S_[(q_) >> 1].w << 16), __uint_as_float(xw##S_[(q_) >> 1].w & 0xffff0000u)} \
                                 : (f32x4){__uint_as_float(xw##S_[(q_) >> 1].x << 16), __uint_as_float(xw##S_[(q_) >> 1].x & 0xffff0000u), __uint_as_float(xw##S_[(q_) >> 1].y << 16), __uint_as_float(xw##S_[(q_) >> 1].y & 0xffff0000u)})
#define RT_BODY(S_, sl_) do { \
                { unsigned pk[8]; \
                  _Pragma("unroll") for (int q = 0; q < 8; ++q) { const f32x4 g = *(const LAS f32x4*)(lnl + 256 * (sl_) + 32 * seg + 4 * q); const f32x4 xq = RT_XV(S_, q); ssq += (xq.x * xq.x + xq.y * xq.y) + (xq.z * xq.z + xq.w * xq.w); \
                      pk[q] = (unsigned)pk4_fp8(sat8(16.0f * xq.x * g.x), sat8(16.0f * xq.y * g.y), sat8(16.0f * xq.z * g.z), sat8(16.0f * xq.w * g.w)); } \
                  GAS v4u* dst = (GAS v4u*)((unsigned char*)H2 + (size_t)(pb + tok_s) * D + 256 * (sl_) + 32 * seg); \
                  dst[0] = (v4u){pk[0], pk[1], pk[2], pk[3]}; dst[1] = (v4u){pk[4], pk[5], pk[6], pk[7]}; } \
                const float gsc = lnl[256 * (sl_) + row]; \
                __syncthreads();                                                \
                _Pragma("unroll") for (int q = 0; q < 8; ++q) *(LAS f32x4*)(xs + tok_s * 260 + 32 * seg + 4 * q) = RT_XV(S_, q); \
                _Pragma("unroll") for (int q = 0; q < 4; ++q) *(LAS f32x4*)(wsl + row * 32 + c0 + 4 * q) = wv[q] * gsc; \
                __syncthreads(); \
                if ((sl_) + 2 < 8) RT_LOAD(S_, (sl_) + 2); if ((sl_) + 1 < 8) RT_LOADW((sl_) + 1); __builtin_amdgcn_sched_barrier(0); \
                _Pragma("unroll") for (int uu = 0; uu < 4; ++uu) { const int u8 = 8 * (4 * wave + uu) + 4 * hh;        \
                    const f32x4 a0 = *(const LAS f32x4*)(xs + r32 * 260 + u8), a1 = *(const LAS f32x4*)(xs + (32 + r32) * 260 + u8); \
                    const LAS float* wp = wsl + u8 * 32 + r32; const float b0 = wp[0], b1 = wp[32], b2 = wp[64], b3 = wp[96]; \
                    macc[0] = __builtin_amdgcn_mfma_f32_32x32x2f32(a0.x, b0, macc[0], 0, 0, 0); macc[1] = __builtin_amdgcn_mfma_f32_32x32x2f32(a1.x, b0, macc[1], 0, 0, 0); \
                    macc[0] = __builtin_amdgcn_mfma_f32_32x32x2f32(a0.y, b1, macc[0], 0, 0, 0); macc[1] = __builtin_amdgcn_mfma_f32_32x32x2f32(a1.y, b1, macc[1], 0, 0, 0); \
                    macc[0] = __builtin_amdgcn_mfma_f32_32x32x2f32(a0.z, b2, macc[0], 0, 0, 0); macc[1] = __builtin_amdgcn_mfma_f32_32x32x2f32(a1.z, b2, macc[1], 0, 0, 0); \
                    macc[0] = __builtin_amdgcn_mfma_f32_32x32x2f32(a0.w, b3, macc[0], 0, 0, 0); macc[1] = __builtin_amdgcn_mfma_f32_32x32x2f32(a1.w, b3, macc[1], 0, 0, 0); if (uu & 1) __builtin_amdgcn_sched_barrier(0); } } while (0)
            RT_LOAD(A, 0); RT_LOAD(B, 1); RT_LOADW(0);
            __syncthreads();
#pragma unroll 1
            for (int sl = 0; sl < 8; sl += 2) { RT_BODY(A, sl); RT_BODY(B, sl + 1); }
#undef RT_BODY
#undef RT_XV
#undef RT_LOAD
#undef RT_LOADW
            ssq += __shfl_xor(ssq, 1); ssq += __shfl_xor(ssq, 2); ssq += __shfl_xor(ssq, 4);
            if (seg == 0) { const float rv = 1.0f / sqrtf(ssq * (1.f / D) + RMS_EPS); rst[tok_s] = rv; RSTD[pb + tok_s] = rv; }
            __syncthreads();
#pragma unroll
            for (int mt = 0; mt < 2; ++mt)
#pragma unroll
                for (int i = 0; i < 16; ++i) xs[(wave * 64 + 32 * mt + (i & 3) + 8 * (i >> 2) + 4 * hh) * 32 + r32] = macc[mt][i];
            __syncthreads();
#pragma unroll
            for (int q = 0; q < 4; ++q) { const int idx = tid + 512 * q; float sacc = 0.f;
#pragma unroll
                for (int w = 0; w < 8; ++w) sacc += xs[w * 2048 + idx];
                wsl[idx] = sacc; }
            __syncthreads();
            const float bias = br[e_];
            int nent = 0;
#pragma unroll
            for (int i = 0; i < 8; ++i) {
                const int t = pb + wave * 8 + i;
                const float lg = wsl[(wave * 8 + i) * 32 + e_] * rst[wave * 8 + i] + bias;
                const unsigned u = __float_as_uint(lg); const unsigned o = (u & 0x80000000u) ? ~u : (u | 0x80000000u);
                unsigned key = (o & ~31u) | (unsigned)(31 - e_);
                float val[4]; int sel[4];
#pragma unroll
                for (int k = 0; k < 4; ++k) { unsigned best = key;
#pragma unroll
                    for (int d = 1; d < 32; d <<= 1) { const unsigned ot = (unsigned)__shfl_xor((int)best, d); best = ot > best ? ot : best; }
                    key = key == best ? 0u : key;
                    sel[k] = 31 - (int)(best & 31u); const unsigned ob = best & ~31u; val[k] = __uint_as_float((ob & 0x80000000u) ? (ob & 0x7fffffffu) : ~ob); }
                const float w0 = 1.0f, w1 = __expf(val[1] - val[0]), w2 = __expf(val[2] - val[0]), w3 = __expf(val[3] - val[0]); const float inv = 1.0f / (w0 + w1 + w2 + w3);
                if (lane < 4) {
                    const int e = lane == 0 ? sel[0] : lane == 1 ? sel[1] : lane == 2 ? sel[2] : sel[3];
                    const float gt_ = (lane == 0 ? w0 : lane == 1 ? w1 : lane == 2 ? w2 : w3) * inv;
                    const unsigned lr = __hip_atomic_fetch_add(lcnt + e, 1u, __ATOMIC_RELAXED, __HIP_MEMORY_SCOPE_WORKGROUP);
                    const int ii = wave * 64 + nent + lane;
                    ent_a[ii] = (unsigned)(t * 4 + lane) | ((unsigned)e << 16) | (lr << 21); ent_g[ii] = gt_;
                }
                nent += 4;
            }
            __syncthreads();
            if (tid < 32) lbase[tid] = __hip_atomic_fetch_add(cnt_g + 64 * tid, lcnt[tid], RLX_AGENT);
            __syncthreads();
            for (int i = lane; i < nent; i += 64) { const unsigned a = ent_a[wave * 64 + i]; const int tk4 = (int)(a & 0xffffu), e = (int)((a >> 16) & 31u); const unsigned rank = lbase[e] + (a >> 21);
                tok_by_e[(size_t)e * T + rank] = tk4 >> 2; route_e[tk4] = e; route_rank[tk4] = (int)rank; route_gate[tk4] = ent_g[wave * 64 + i]; }
            __syncthreads();
        }
    }
    SEAM(10);
    if (IN(12)) { PH_PTRS;
        moe_tiles(cnt_g, lds, tid);
        const LAS int* texp = (const LAS int*)(lds + TEXP_OFF); const int nMt = *(const LAS int*)(lds + NMT_OFF);
        pg8::Gemm g{(const bf16*)H2, W1_T, nMt * 256, HID, D, D, D};
        pg8::GatherOrder<FF, D, 4, 2> S; S.init(nMt * 256, HID, G, bx); S.texp = texp; S.estride = (size_t)HID * D; S.ub = 0 - ((bx >> 3) & 3); S.ucount = 0;
        S.wsrc = &ka->in[27]; S.wsp = &ka->ws; S.wsoff = WS_W2;
        S.ldsb = lds;
        pg8::EpiSwiglu E{(unsigned char*)ACT, ka->in[26], texp, RSTD, (const LAS int*)(lds + TOKT_OFF)};
        pg8::gemm_phase<pg8::EpiSwiglu, pg8::GatherOrder<FF, D, 4, 2>, true, true, 1>(lds + RING_OFF, g, S, E);
        for (int it_ = gw + 8 * NGW; it_ < NE * I_2; it_ += NGW) { const int e_ = it_ / I_2; p0_tr8_item_h(ka->in[27] + (size_t)e_ * FF * D, FF, D, (unsigned char*)W2_T + (size_t)e_ * D * FF, it_ % I_2, lane, 512.0f); }
    }
    SEAM(12);
    if (IN(13)) { PH_PTRS;
        moe_tiles(cnt_g, lds, tid);
        const LAS int* texp = (const LAS int*)(lds + TEXP_OFF); const int nMt = *(const LAS int*)(lds + NMT_OFF);
        pg8::Gemm g{ACT, W2_T, nMt * 256, D, FF, FF, FF}; pg8::StaticOrder S; S.init(nMt * 256, D, G, bx); S.texp = texp; S.estride = (size_t)D * FF;
        pg8::EpiEo E{(unsigned char*)EO, ka->in[28], texp};
        pg8::gemm_phase<pg8::EpiEo, pg8::StaticOrder, true, true, 1>(lds + RING_OFF, g, S, E);
    }
    SEAM(13);
    if (IN(14)) { PH_PTRS;
        moe_tiles(cnt_g, lds, tid);
        const LAS int* pads = (const LAS int*)(lds + PADS_OFF);
        for (int t = gw; t < T; t += NGW) {
            int slot[4]; float gk[4];
#pragma unroll
            for (int k = 0; k < 4; ++k) { slot[k] = pads[route_e[t * 4 + k]] + route_rank[t * 4 + k]; gk[k] = route_gate[t * 4 + k]; }
            GAS f32x4* orow = (GAS f32x4*)(out + (size_t)t * D);
            typedef float f32x2c __attribute__((ext_vector_type(2)));
            v4u w[2][4]; f32x4 a[2][4];
#pragma unroll
            for (int j = 0; j < 2; ++j) { const int c16 = lane + 64 * j;
#pragma unroll
                for (int q = 0; q < 2; ++q) { const v4u xa = *((const GAS v4u*)(YB + (size_t)t * D) + 2 * c16 + q);
                    a[j][2 * q] = (f32x4){__uint_as_float(xa.x << 16), __uint_as_float(xa.x & 0xffff0000u), __uint_as_float(xa.y << 16), __uint_as_float(xa.y & 0xffff0000u)};
                    a[j][2 * q + 1] = (f32x4){__uint_as_float(xa.z << 16), __uint_as_float(xa.z & 0xffff0000u), __uint_as_float(xa.w << 16), __uint_as_float(xa.w & 0xffff0000u)}; }
#pragma unroll
                for (int k = 0; k < 4; ++k) w[j][k] = *((const GAS v4u*)((const unsigned char*)EO + (size_t)slot[k] * D) + c16); }
#pragma unroll
            for (int j = 0; j < 2; ++j) { const int c16 = lane + 64 * j;
#pragma unroll
                for (int k = 0; k < 4; ++k) { const float g = gk[k] * (1.0f / 32.0f);
#pragma unroll
                    for (int q = 0; q < 4; ++q) { const unsigned ww = q == 0 ? w[j][k].x : q == 1 ? w[j][k].y : q == 2 ? w[j][k].z : w[j][k].w;
                        const f32x2c lo = __builtin_amdgcn_cvt_pk_f32_fp8((int)ww, false), hi = __builtin_amdgcn_cvt_pk_f32_fp8((int)ww, true);
                        a[j][q].x += g * lo.x; a[j][q].y += g * lo.y; a[j][q].z += g * hi.x; a[j][q].w += g * hi.y; } }
#pragma unroll
                for (int q = 0; q < 4; ++q) orow[4 * c16 + q] = a[j][q]; }
        }
    }
#undef IN
#undef SEAM
}

extern "C" void kernel_launch(void* const* d_in, const int* in_sizes, int n_in, void* d_out, int out_size, void* d_ws, size_t ws_size, hipStream_t stream) {
    static int grid = 0;
    if (grid == 0) {
        if (n_in != 29 || out_size != T * D || ws_size < WS_END) { fprintf(stderr, "kernel_launch: unexpected shapes (n_in %d out %d ws %zu)\n", n_in, out_size, ws_size); grid = -1; return; }
        int dev = 0, cus = 0, per_cu = 0;
        if (hipGetDevice(&dev) != hipSuccess || hipDeviceGetAttribute(&cus, hipDeviceAttributeMultiprocessorCount, dev) != hipSuccess) { grid = -1; return; }
        if (hipFuncSetAttribute((const void*)fwd_kernel, hipFuncAttributeMaxDynamicSharedMemorySize, LDS_BYTES) != hipSuccess) { fprintf(stderr, "kernel_launch: hipFuncSetAttribute failed\n"); grid = -1; return; }
        if (hipOccupancyMaxActiveBlocksPerMultiprocessor(&per_cu, (const void*)fwd_kernel, NTHR, LDS_BYTES) != hipSuccess || per_cu < 1) fprintf(stderr, "kernel_launch: occupancy query reports %d\n", per_cu);
        (void)hipGetLastError();
        grid = cus;
    }
    if (grid < 0) return;
    (void)hipMemsetAsync((char*)d_ws + WS_CTL, 0, CTL_ZERO_BYTES, stream);
    Args a{};
    for (int i = 0; i < 29; ++i) a.in[i] = (const float*)d_in[i];
    a.out = (float*)d_out; a.ws = (unsigned char*)d_ws;
#ifndef N_LAUNCH_SPLIT
#define N_LAUNCH_SPLIT 0
#endif
#if N_LAUNCH_SPLIT
    for (int ph = 0; ph < NPHASE; ++ph) { a.ph_lo = ph; a.ph_hi = ph + 1; hipLaunchKernelGGL(fwd_kernel, dim3(grid), dim3(NTHR), LDS_BYTES, stream, a); }
#else
    a.ph_lo = 0; a.ph_hi = NPHASE; hipLaunchKernelGGL(fwd_kernel, dim3(grid), dim3(NTHR), LDS_BYTES, stream, a);
#endif
}
```
